# Optimizing an MI355X kernel written in HIP

```python
import jax, jax.numpy as jnp
from jax import lax
import numpy as np

D_MODEL = 2048
BATCH = 1
SEQ = 16384
DEPTH = 1

D_CONV = D_MODEL // 2
CONV_WIDTH = 3
N_HEADS = 16
N_KV_HEADS = 4
HEAD_DIM = 64
D_ATTN = N_HEADS * HEAD_DIM
D_KV = N_KV_HEADS * HEAD_DIM
WINDOW = 128
BLOCK = 128
ROPE_THETA = 10000.0
N_BRANCH = 2
D_FF = 5632
EPS = 1e-6

SPLIT_SIZES = (D_CONV, D_CONV, D_CONV, D_ATTN, D_KV, D_KV, D_MODEL, D_MODEL)
SPLIT_POINTS = tuple(int(p) for p in np.cumsum(SPLIT_SIZES)[:-1])
D_IN_PROJ = int(sum(SPLIT_SIZES))

kernel_name = "hybrid_gated_shortconv_swa_convffn"


def rmsnorm(x, g):
    xf = x.astype(jnp.float32)
    y = xf * lax.rsqrt(jnp.mean(xf * xf, axis=-1, keepdims=True) + EPS)
    return (y * g.astype(jnp.float32)).astype(x.dtype)


def centred_dwconv3(x, w):
    xp = jnp.pad(x, ((0, 0), (1, 1), (0, 0)))
    return xp[:, :-2] * w[0] + xp[:, 1:-1] * w[1] + xp[:, 2:] * w[2]


def rope(x, seq_len):
    half = HEAD_DIM // 2
    inv_freq = ROPE_THETA ** (-jnp.arange(0, half, dtype=jnp.float32) / half)
    ang = jnp.arange(seq_len, dtype=jnp.float32)[:, None] * inv_freq[None, :]
    cos = jnp.cos(ang)[None, :, None, :]
    sin = jnp.sin(ang)[None, :, None, :]
    xf = x.astype(jnp.float32)
    x1, x2 = xf[..., :half], xf[..., half:]
    out = jnp.concatenate([x1 * cos - x2 * sin, x2 * cos + x1 * sin], axis=-1)
    return out.astype(x.dtype)


def banded_window_attention(q, k, v, sink):
    b, s = q.shape[0], q.shape[1]
    nb = s // BLOCK
    grp = N_HEADS // N_KV_HEADS
    qb = q.reshape(b, nb, BLOCK, N_KV_HEADS, grp, HEAD_DIM)
    pad = ((0, 0), (BLOCK, BLOCK), (0, 0), (0, 0))
    kp = jnp.pad(k, pad).reshape(b, nb + 2, BLOCK, N_KV_HEADS, HEAD_DIM)
    vp = jnp.pad(v, pad).reshape(b, nb + 2, BLOCK, N_KV_HEADS, HEAD_DIM)
    kb = jnp.concatenate([kp[:, :-2], kp[:, 1:-1], kp[:, 2:]], axis=2)
    vb = jnp.concatenate([vp[:, :-2], vp[:, 1:-1], vp[:, 2:]], axis=2)
    scale = HEAD_DIM ** -0.5
    scores = jnp.einsum('bnqkgd,bnskd->bnkgqs', qb, kb).astype(jnp.float32) * scale
    blk = jnp.arange(nb)[:, None, None]
    qpos = blk * BLOCK + jnp.arange(BLOCK)[None, :, None]
    kpos = (blk - 1) * BLOCK + jnp.arange(3 * BLOCK)[None, None, :]
    mask = (jnp.abs(kpos - qpos) <= WINDOW) & (kpos >= 0) & (kpos < s)
    scores = jnp.where(mask[None, :, None, None], scores, -jnp.inf)
    sk = sink.astype(jnp.float32).reshape(1, 1, N_KV_HEADS, grp, 1)
    m = jnp.maximum(jnp.max(scores, axis=-1), sk)
    p = jnp.exp(scores - m[..., None])
    denom = jnp.sum(p, axis=-1) + jnp.exp(sk - m)
    p = (p / denom[..., None]).astype(v.dtype)
    out = jnp.einsum('bnkgqs,bnskd->bnqkgd', p, vb)
    return out.reshape(b, s, N_HEADS, HEAD_DIM)


def setup_inputs(seed: int = 0) -> dict:
    key = jax.random.key(seed)
    ks = jax.random.split(key, 16)
    f32 = jnp.float32

    def nrm(k, shape, fan_in):
        return jax.random.normal(k, shape, f32) * (fan_in ** -0.5)

    x = jax.random.normal(ks[0], (BATCH, SEQ, D_MODEL), f32)
    return {
        "x": x,
        "norm_mix_g": 1.0 + 0.02 * jax.random.normal(ks[1], (DEPTH, D_MODEL), f32),
        "w_in": nrm(ks[2], (DEPTH, D_MODEL, D_IN_PROJ), D_MODEL),
        "b_gate": 0.02 * jax.random.normal(ks[3], (DEPTH, N_BRANCH * D_MODEL), f32),
        "conv_a_w": nrm(ks[4], (DEPTH, CONV_WIDTH, D_CONV), CONV_WIDTH),
        "w_out_a": nrm(ks[5], (DEPTH, D_CONV, D_MODEL), D_CONV),
        "sink_logits": 0.5 * jax.random.normal(ks[6], (DEPTH, N_HEADS), f32),
        "w_o_attn": nrm(ks[7], (DEPTH, D_ATTN, D_MODEL), D_ATTN),
        "w_mix_out": nrm(ks[8], (DEPTH, D_MODEL, D_MODEL), D_MODEL),
        "norm_ffn_g": 1.0 + 0.02 * jax.random.normal(ks[9], (DEPTH, D_MODEL), f32),
        "ffn_w_up": nrm(ks[10], (DEPTH, D_MODEL, 2 * D_FF), D_MODEL),
        "ffn_conv_w": nrm(ks[11], (DEPTH, CONV_WIDTH, 2 * D_FF), CONV_WIDTH),
        "ffn_conv_b": 0.02 * jax.random.normal(ks[12], (DEPTH, 2 * D_FF), f32),
        "ffn_w_down": nrm(ks[13], (DEPTH, D_FF, D_MODEL), D_FF),
        "norm_final_g": 1.0 + 0.02 * jax.random.normal(ks[14], (D_MODEL,), f32),
    }


def reference(x, norm_mix_g, w_in, b_gate, conv_a_w, w_out_a, sink_logits, w_o_attn,
              w_mix_out, norm_ffn_g, ffn_w_up, ffn_conv_w, ffn_conv_b, ffn_w_down,
              norm_final_g):
    b, s, _ = x.shape
    h = x
    for l in range(DEPTH):
        u = rmsnorm(h, norm_mix_g[l])
        z = u @ w_in[l]
        b_a, c_a, v_a, q, k, v, gl_a, gl_b = jnp.split(z, SPLIT_POINTS, axis=-1)
        y_a = (b_a * centred_dwconv3(c_a * v_a, conv_a_w[l])) @ w_out_a[l]
        q = rope(q.reshape(b, s, N_HEADS, HEAD_DIM), s)
        k = rope(k.reshape(b, s, N_KV_HEADS, HEAD_DIM), s)
        v = v.reshape(b, s, N_KV_HEADS, HEAD_DIM)
        att = banded_window_attention(q, k, v, sink_logits[l])
        y_b = att.reshape(b, s, D_ATTN) @ w_o_attn[l]
        g_a = jax.nn.sigmoid(gl_a + b_gate[l, :D_MODEL])
        g_b = jax.nn.sigmoid(gl_b + b_gate[l, D_MODEL:])
        h = h + (g_a * y_a + g_b * y_b) @ w_mix_out[l]
        u2 = rmsnorm(h, norm_ffn_g[l])
        up = centred_dwconv3(u2 @ ffn_w_up[l], ffn_conv_w[l]) + ffn_conv_b[l]
        a, gv = up[..., :D_FF], up[..., D_FF:]
        h = h + (jax.nn.silu(a) * gv) @ ffn_w_down[l]
    return rmsnorm(h, norm_final_g)
```

```cpp
#include <hip/hip_runtime.h>
#include <hip/hip_cooperative_groups.h>
#include <cstdio>
#include <cstdint>
namespace cg = cooperative_groups;
#ifndef MK_N_LAUNCHES
#define MK_N_LAUNCHES 11
#endif
namespace pg8 {
#define PG8_LAS __attribute__((address_space(3)))
typedef unsigned short bf16_t;
typedef short bf16x8 __attribute__((ext_vector_type(8)));
typedef float f32x4 __attribute__((ext_vector_type(4)));
typedef unsigned u32x4 __attribute__((ext_vector_type(4)));
constexpr int BM = 256, BK = 64, HALF = 128, HTB = HALF * BK * 2  , STAGE_BYTES = 8 * HTB, NXCD = 8, WGM = 8;

__host__ __device__ __forceinline__ int lds_byte(int r, int c) { const int st = (r >> 4) * 2 + (c >> 5), rr = r & 15, cc = c & 31, ob = rr * 64 + cc * 2; return st * 1024 + (ob ^ (((ob >> 9) & 1) << 5)); }
__host__ __device__ __forceinline__ void stage_rc(int b, int& R, int& C) { const int st = b / 1024, sb = b % 1024, swz = sb ^ (((sb >> 9) & 1) << 5); R = (st >> 1) * 16 + swz / 64; C = (st & 1) * 32 + (swz % 64) / 2; }
__host__ __device__ __forceinline__ int perm32(int rho) { const int n = rho >> 4, i = rho & 15; return 8 * (i >> 2) + 4 * n + (i & 3); }

struct Unit { int pm, pn; };
struct Gemm { const bf16_t* A; const bf16_t* Bt; int M, N, K; };

struct StaticOrder {
    int nM, nN, nwg, G, c;
    __host__ __device__ void init(int M, int N, int G_, int c_) { nM = M / BM; nN = N / BM; nwg = nM * nN; G = G_; c = c_; }
    __host__ __device__ bool next(int i, Unit& u) const {
        const long L = (long)i * G + c; if (L >= nwg) return false;
        int wgid = (int)L; { const int q = nwg / NXCD, r = nwg % NXCD, xcd = wgid % NXCD, off = wgid / NXCD; wgid = (xcd < r ? xcd * (q + 1) : r * (q + 1) + (xcd - r) * q) + off; }
        const int nig = WGM * nN, gid = wgid / nig, fm = gid * WGM, gsz = (nM - fm) < WGM ? (nM - fm) : WGM;
        u.pm = fm + ((wgid % nig) % gsz); u.pn = (wgid % nig) / gsz; return true;
    }
    __device__ __forceinline__ const char* pa(const Gemm& g, const Unit& u, size_t tstep) const { return (const char*)g.A + (size_t)u.pm * tstep; }
    __device__ __forceinline__ const char* pb(const Gemm& g, const Unit& u, size_t tstep) const { return (const char*)g.Bt + (size_t)u.pn * tstep; }
    __device__ __forceinline__ void a_ready(const Unit&) const {}
    __device__ __forceinline__ void done(const Unit&) const {}
};

__device__ __forceinline__ unsigned cvt_pk_bf16(float lo, float hi) { unsigned r; asm volatile("v_cvt_pk_bf16_f32 %0, %1, %2" : "=v"(r) : "v"(lo), "v"(hi)); return r; }
typedef float f32x2 __attribute__((ext_vector_type(2)));
template <class Epi, class Sched, bool ALIGN_EPI = false, bool SP2 = false>
__device__ __forceinline__ void gemm_phase(PG8_LAS unsigned char* lds, const Gemm g, const Sched& S, const Epi& E) {
    const int tid = threadIdx.x, wid = __builtin_amdgcn_readfirstlane(tid >> 6), lane = tid & 63, wr = wid >> 2, wc = wid & 3, fr = lane & 15, fq = lane >> 4;
    const int K = g.K, nt = K / BK;
    unsigned voffA[2], voffB[2];
#pragma unroll
    for (int i = 0; i < 2; ++i) { int R, C; stage_rc(tid * 16 + i * 8192, R, C); const int Rb = Epi::PERM ? ((R & ~31) + perm32(R & 31)) : R;
        voffA[i] = (unsigned)(R * K + C) * 2u; voffB[i] = (unsigned)(Rb * K + C) * 2u; }
    const size_t kstep = (size_t)(BK * 2);
    const size_t hstep = (size_t)HALF * K * 2;
    const size_t tstep = 2 * hstep;
    const unsigned ldsw = (unsigned)wid * 1024u;
    const int aoff = lds_byte(wr * 64 + fr, fq * 8), boff = lds_byte(wc * 32 + fr, fq * 8);
#define PG8_SA(b, h) (((b) * 2 + (h)) * HTB)
#define PG8_SB(b, h) ((4 + (b) * 2 + (h)) * HTB)
#define PG8_STAGE(bufoff, gbase, voff) do { _Pragma("unroll") for (int _i = 0; _i < 2; ++_i) \
        __builtin_amdgcn_global_load_lds((const unsigned*)((const char*)(gbase) + (voff)[_i]), (PG8_LAS unsigned*)(lds + (bufoff) + ldsw + _i * 8192), 16, 0, 0); } while (0)
#define PG8_LDA(dst, b, h) do { _Pragma("unroll") for (int m = 0; m < 4; ++m) _Pragma("unroll") for (int k = 0; k < 2; ++k) dst[m][k] = *(const PG8_LAS bf16x8*)(lds + PG8_SA(b, h) + aoff + m * 2048 + k * 1024); } while (0)
#define PG8_LDB(dst, b, h) do { _Pragma("unroll") for (int n = 0; n < 2; ++n) _Pragma("unroll") for (int k = 0; k < 2; ++k) dst[n][k] = *(const PG8_LAS bf16x8*)(lds + PG8_SB(b, h) + boff + n * 2048 + k * 1024); } while (0)
#define PG8_MMA(ai, bj, At, Bt) do { __builtin_amdgcn_s_setprio(1); _Pragma("unroll") for (int m = 0; m < 4; ++m) _Pragma("unroll") for (int n = 0; n < 2; ++n) _Pragma("unroll") for (int k = 0; k < 2; ++k) \
        acc[ai][bj][m][n] = __builtin_amdgcn_mfma_f32_16x16x32_bf16(Bt[n][k], At[m][k], acc[ai][bj][m][n], 0, 0, 0); __builtin_amdgcn_s_setprio(0); } while (0)
#define PG8_WAIT_V(n) asm volatile("s_waitcnt vmcnt(" #n ")" ::: "memory")
#define PG8_WAIT_L(n) asm volatile("s_waitcnt lgkmcnt(" #n ")" ::: "memory")
#define PG8_BAR __builtin_amdgcn_s_barrier()
#define PG8_SCHED __builtin_amdgcn_sched_barrier(0)
    Unit cur, nxt; int ui = 0;
    if (!S.next(0, cur)) return;
    f32x4 acc[2][2][4][2];
#pragma unroll
    for (int a = 0; a < 2; ++a)
#pragma unroll
        for (int b = 0; b < 2; ++b)
#pragma unroll
            for (int m = 0; m < 4; ++m)
#pragma unroll
                for (int n = 0; n < 2; ++n) acc[a][b][m][n] = (f32x4){0.f, 0.f, 0.f, 0.f};
    bf16x8 At[4][2], B0[2][2], B1[2][2];
    const char* cA = S.pa(g, cur, tstep); const char* cB = S.pb(g, cur, tstep);
    S.a_ready(cur);
    if constexpr (SP2) {
        PG8_STAGE(PG8_SB(0, 0), cB, voffB); PG8_STAGE(PG8_SB(0, 1), cB + hstep, voffB); PG8_STAGE(PG8_SA(0, 0), cA, voffA); PG8_STAGE(PG8_SA(0, 1), cA + hstep, voffA);
        if (wr == 1) PG8_BAR;
        PG8_WAIT_V(2); PG8_BAR;
        PG8_STAGE(PG8_SB(1, 0), cB + kstep, voffB); PG8_STAGE(PG8_SA(1, 0), cA + kstep, voffA); PG8_STAGE(PG8_SB(1, 1), cB + hstep + kstep, voffB);
        PG8_WAIT_V(6); PG8_BAR;
    } else {
        PG8_STAGE(PG8_SB(0, 0), cB, voffB); PG8_STAGE(PG8_SA(0, 0), cA, voffA); PG8_STAGE(PG8_SB(0, 1), cB + hstep, voffB); PG8_STAGE(PG8_SA(0, 1), cA + hstep, voffA);
        if (wr == 1) PG8_BAR;
        PG8_WAIT_V(4); PG8_BAR;
        PG8_STAGE(PG8_SB(1, 0), cB + kstep, voffB); PG8_STAGE(PG8_SA(1, 0), cA + kstep, voffA); PG8_STAGE(PG8_SB(1, 1), cB + hstep + kstep, voffB);
        PG8_WAIT_V(6); PG8_BAR;
    }
    for (;;) {
        const bool has_next = S.next(ui + 1, nxt);
        const char* nA = has_next ? S.pa(g, nxt, tstep) : cA; const char* nB = has_next ? S.pb(g, nxt, tstep) : cB;
        for (int t = 0; t < nt; t += 2) {
            const bool last = (t == nt - 2);
            const char* a1 = cA + (size_t)(t + 1) * kstep;
            const char* a2 = last ? nA : cA + (size_t)(t + 2) * kstep; const char* b2 = last ? nB : cB + (size_t)(t + 2) * kstep;
            const char* a3 = a2 + kstep; const char* b3 = b2 + kstep;
            if (last && has_next) S.a_ready(nxt);
            if constexpr (SP2) {
            PG8_LDB(B0, 0, 0); PG8_LDB(B1, 0, 1); PG8_SCHED; PG8_LDA(At, 0, 0); PG8_STAGE(PG8_SA(1, 1), a1 + hstep, voffA);
            PG8_WAIT_V(8); PG8_WAIT_L(0); PG8_BAR; PG8_MMA(0, 0, At, B0); PG8_MMA(0, 1, At, B1); PG8_BAR; PG8_SCHED;
            PG8_LDA(At, 0, 1); PG8_STAGE(PG8_SB(0, 0), b2, voffB); PG8_STAGE(PG8_SB(0, 1), b2 + hstep, voffB); PG8_STAGE(PG8_SA(0, 0), a2, voffA);
            PG8_WAIT_V(8); PG8_WAIT_L(0); PG8_BAR; PG8_MMA(1, 0, At, B0); PG8_MMA(1, 1, At, B1); PG8_BAR; PG8_SCHED;
            PG8_LDB(B0, 1, 0); PG8_LDB(B1, 1, 1); PG8_SCHED; PG8_LDA(At, 1, 0); PG8_STAGE(PG8_SA(0, 1), a2 + hstep, voffA);
            PG8_WAIT_V(8); PG8_WAIT_L(0); PG8_BAR; PG8_MMA(0, 0, At, B0); PG8_MMA(0, 1, At, B1); PG8_BAR; PG8_SCHED;
            PG8_LDA(At, 1, 1); PG8_STAGE(PG8_SB(1, 0), b3, voffB); PG8_STAGE(PG8_SB(1, 1), b3 + hstep, voffB); PG8_STAGE(PG8_SA(1, 0), a3, voffA);
            PG8_WAIT_V(8); PG8_WAIT_L(0); PG8_BAR; PG8_MMA(1, 0, At, B0); PG8_MMA(1, 1, At, B1); PG8_BAR; PG8_SCHED;
            } else {
            PG8_LDB(B0, 0, 0); PG8_SCHED; PG8_LDA(At, 0, 0); PG8_STAGE(PG8_SA(1, 1), a1 + hstep, voffA);
            PG8_WAIT_L(8); PG8_BAR; PG8_WAIT_L(0); PG8_MMA(0, 0, At, B0); PG8_BAR; PG8_SCHED;
            PG8_LDB(B1, 0, 1); PG8_STAGE(PG8_SB(0, 0), b2, voffB);
            PG8_BAR; PG8_WAIT_L(0); PG8_MMA(0, 1, At, B1); PG8_BAR;
            PG8_LDA(At, 0, 1); PG8_STAGE(PG8_SA(0, 0), a2, voffA);
            PG8_BAR; PG8_WAIT_L(0); PG8_MMA(1, 0, At, B0); PG8_BAR; PG8_SCHED;
            PG8_STAGE(PG8_SB(0, 1), b2 + hstep, voffB);
            PG8_WAIT_V(6); PG8_BAR; PG8_MMA(1, 1, At, B1); PG8_BAR;
            PG8_LDB(B0, 1, 0); PG8_SCHED; PG8_LDA(At, 1, 0); PG8_STAGE(PG8_SA(0, 1), a2 + hstep, voffA);
            PG8_WAIT_L(8); PG8_BAR; PG8_WAIT_L(0); PG8_MMA(0, 0, At, B0); PG8_BAR; PG8_SCHED;
            PG8_LDB(B1, 1, 1); PG8_STAGE(PG8_SB(1, 0), b3, voffB);
            PG8_BAR; PG8_WAIT_L(0); PG8_MMA(0, 1, At, B1); PG8_BAR;
            PG8_LDA(At, 1, 1); PG8_STAGE(PG8_SA(1, 0), a3, voffA);
            PG8_BAR; PG8_WAIT_L(0); PG8_MMA(1, 0, At, B0); PG8_BAR; PG8_SCHED;
            PG8_STAGE(PG8_SB(1, 1), b3 + hstep, voffB);
            PG8_WAIT_V(6); PG8_BAR; PG8_MMA(1, 1, At, B1); PG8_BAR;
            }
        }
        if constexpr (ALIGN_EPI) { if (wr == 0) PG8_BAR; }
        if constexpr (!Epi::AFTER_DRAIN) { E(acc, cur, wr, wc, fr, fq); S.done(cur); }
        if (!has_next) break;
#pragma unroll
        for (int a = 0; a < 2; ++a)
#pragma unroll
            for (int b = 0; b < 2; ++b)
#pragma unroll
                for (int m = 0; m < 4; ++m)
#pragma unroll
                    for (int n = 0; n < 2; ++n) acc[a][b][m][n] = (f32x4){0.f, 0.f, 0.f, 0.f};
        cur = nxt; cA = nA; cB = nB; ++ui;
        if constexpr (ALIGN_EPI) { if (wr == 1) PG8_BAR; }
    }
    PG8_WAIT_V(0);
    if constexpr (!ALIGN_EPI) { if (wr == 0) PG8_BAR; }
    PG8_BAR;
    if constexpr (Epi::AFTER_DRAIN) { E.fused(acc, cur, wr, wc, fr, fq, lds, wid, lane); S.done(cur); }
#undef PG8_SA
#undef PG8_SB
#undef PG8_STAGE
#undef PG8_LDA
#undef PG8_LDB
#undef PG8_MMA
#undef PG8_WAIT_V
#undef PG8_WAIT_L
#undef PG8_BAR
#undef PG8_SCHED
}
}

using pg8::bf16_t; using pg8::bf16x8; using pg8::f32x4; using pg8::u32x4; using pg8::cvt_pk_bf16; using pg8::Unit; using pg8::Gemm;
#define LAS __attribute__((address_space(3)))
typedef float f32x16 __attribute__((ext_vector_type(16)));
typedef unsigned u32x2 __attribute__((ext_vector_type(2)));
constexpr int SEQ = 16384, DM = 2048, DCONV = 1024, NH = 16, NKV = 4, HD = 64, DATT = 1024, DFF = 5632, FFH = 2816;
constexpr int DIN = 8704;
constexpr int C_BA = 0, C_CA = 1024, C_VA = 2048, C_Q = 3072, C_K = 4096, C_V = 4352, C_GA = 4608, C_GB = 6656;
constexpr float EPS = 1e-6f;
constexpr float LOG2E = 1.4426950408889634f;
constexpr float QSCALE = 0.125f * 1.4426950408889634f;
constexpr int NWAVES = 8, NTHREADS = 512;
constexpr int LDS_BYTES = 147456;

constexpr size_t MiB = (size_t)1 << 20;
constexpr size_t WS_SSQ2 = 0, WS_SSQ3 = 65536, WS_RSTD1 = 131072;
constexpr size_t WS_COS = 1 * MiB, WS_SIN = 3 * MiB;
constexpr size_t WS_WUP = 6 * MiB, WS_WDOWN = 50 * MiB;
constexpr size_t WS_Z = 72 * MiB;
constexpr size_t WS_H1B = 72 * MiB;
constexpr size_t WS_VT = 344 * MiB;
constexpr size_t WS_XB = 352 * MiB, WS_MB = 352 * MiB;
constexpr size_t WS_WIN = 416 * MiB, WS_BT3 = 450 * MiB, WS_WMIX = 458 * MiB;
constexpr size_t WS_UPS = 136 * MiB;
constexpr size_t WS_ACT = 312 * MiB;
constexpr size_t WS_END = 488 * MiB;

__device__ __forceinline__ void unpack8(const u32x4 w, float (&f)[8]) {
    f[0] = __uint_as_float(w.x << 16); f[1] = __uint_as_float(w.x & 0xffff0000u);
    f[2] = __uint_as_float(w.y << 16); f[3] = __uint_as_float(w.y & 0xffff0000u);
    f[4] = __uint_as_float(w.z << 16); f[5] = __uint_as_float(w.z & 0xffff0000u);
    f[6] = __uint_as_float(w.w << 16); f[7] = __uint_as_float(w.w & 0xffff0000u);
}
__device__ __forceinline__ u32x4 pack8(const float (&f)[8]) {
    u32x4 w; w.x = cvt_pk_bf16(f[0], f[1]); w.y = cvt_pk_bf16(f[2], f[3]); w.z = cvt_pk_bf16(f[4], f[5]); w.w = cvt_pk_bf16(f[6], f[7]); return w;
}
__device__ __forceinline__ float sigmoidf_(float v) { return __builtin_amdgcn_rcpf(1.0f + __builtin_amdgcn_exp2f(-v * LOG2E)); }
__device__ __forceinline__ float wave_sum(float v) {
#pragma unroll
    for (int o = 1; o < 64; o <<= 1) v += __shfl_xor(v, o);
    return v;
}

struct Sched1 {
    pg8::StaticOrder so;
    __device__ void init(int G, int c) { so.init(SEQ, DIN, G, c); }
    __device__ bool next(int i, Unit& u) const { return so.next(i, u); }
    __device__ __forceinline__ const char* pa(const Gemm& g, const Unit& u, size_t tstep) const { return u.pn == 17 ? (const char*)g.Bt + (size_t)17 * tstep : (const char*)g.A + (size_t)u.pm * tstep; }
    __device__ __forceinline__ const char* pb(const Gemm& g, const Unit& u, size_t tstep) const { return u.pn == 17 ? (const char*)g.A + (size_t)u.pm * tstep : (const char*)g.Bt + (size_t)u.pn * tstep; }
    __device__ __forceinline__ void a_ready(const Unit&) const {}
    __device__ __forceinline__ void done(const Unit&) const {}
};
struct Sched3 {
    pg8::StaticOrder so;
    __device__ void init(int G, int c) { so.init(SEQ, DM, G, c); }
    __device__ bool next(int i, Unit& u) const { if (!so.next(i >> 1, u)) return false; if (i & 1) { u.pm += 64; u.pn += 8; } return true; }
    __device__ __forceinline__ const char* pa(const Gemm& g, const Unit& u, size_t tstep) const { return (const char*)g.A + (size_t)u.pm * tstep; }
    __device__ __forceinline__ const char* pb(const Gemm& g, const Unit& u, size_t tstep) const { return (const char*)g.Bt + (size_t)u.pn * tstep; }
    __device__ __forceinline__ void a_ready(const Unit&) const {}
    __device__ __forceinline__ void done(const Unit&) const {}
};

struct Epi1 {
    static constexpr bool PERM = true, AFTER_DRAIN = false;
    bf16_t* z; bf16_t* vT; const float* rstd1; const float* cosT; const float* sinT; const float* bgate;
    __device__ __forceinline__ void operator()(const f32x4 (&acc)[2][2][4][2], const Unit& u, int wr, int wc, int fr, int fq) const {
        if (u.pn == 17) {
#pragma unroll
            for (int bj = 0; bj < 2; ++bj) {
                const int tok0 = u.pm * 256 + bj * 128 + wc * 32 + 8 * fq;
                const f32x4 r0 = *(const f32x4*)(rstd1 + tok0), r1 = *(const f32x4*)(rstd1 + tok0 + 4);
#pragma unroll
                for (int ai = 0; ai < 2; ++ai)
#pragma unroll
                    for (int m = 0; m < 4; ++m) {
                        const int d = ai * 128 + wr * 64 + m * 16 + fr;
                        const f32x4 v0 = acc[ai][bj][m][0] * r0, v1 = acc[ai][bj][m][1] * r1;
                        u32x4 w; w.x = cvt_pk_bf16(v0[0], v0[1]); w.y = cvt_pk_bf16(v0[2], v0[3]); w.z = cvt_pk_bf16(v1[0], v1[1]); w.w = cvt_pk_bf16(v1[2], v1[3]);
                        *(u32x4*)(vT + (size_t)d * SEQ + tok0) = w;
                    }
            }
            return;
        }
        const int kind = u.pn < 12 ? 0 : (u.pn < 17 ? 1 : 2);
#pragma unroll
        for (int ai = 0; ai < 2; ++ai)
#pragma unroll
            for (int m = 0; m < 4; ++m) {
                const int row = u.pm * 256 + ai * 128 + wr * 64 + m * 16 + fr;
                const float rs = rstd1[row];
                bf16_t* zr = z + (size_t)row * DIN;
#pragma unroll
                for (int bj = 0; bj < 2; ++bj) {
                    const int col0 = u.pn * 256 + bj * 128 + wc * 32 + 8 * fq;
                    f32x4 v0 = acc[ai][bj][m][0] * rs, v1 = acc[ai][bj][m][1] * rs;
                    if (kind == 1) {
                        const int hb = col0 & ~63, G4 = ((col0 & 63) >> 3) * 4;
                        const f32x4 cs = *(const f32x4*)(cosT + (size_t)row * 32 + G4), sn = *(const f32x4*)(sinT + (size_t)row * 32 + G4);
                        f32x4 o0 = v0 * cs - v1 * sn, o1 = v1 * cs + v0 * sn;
                        if (u.pn < 16) { o0 = o0 * QSCALE; o1 = o1 * QSCALE; }
                        u32x2 w0, w1; w0.x = cvt_pk_bf16(o0[0], o0[1]); w0.y = cvt_pk_bf16(o0[2], o0[3]); w1.x = cvt_pk_bf16(o1[0], o1[1]); w1.y = cvt_pk_bf16(o1[2], o1[3]);
                        *(u32x2*)(zr + hb + G4) = w0; *(u32x2*)(zr + hb + 32 + G4) = w1;
                    } else {
                        if (kind == 2) {
                            const f32x4 b0 = *(const f32x4*)(bgate + (col0 - C_GA)), b1 = *(const f32x4*)(bgate + (col0 - C_GA) + 4);
                            v0 = v0 + b0; v1 = v1 + b1;
#pragma unroll
                            for (int j = 0; j < 4; ++j) { v0[j] = sigmoidf_(v0[j]); v1[j] = sigmoidf_(v1[j]); }
                        }
                        u32x4 w; w.x = cvt_pk_bf16(v0[0], v0[1]); w.y = cvt_pk_bf16(v0[2], v0[3]); w.z = cvt_pk_bf16(v1[0], v1[1]); w.w = cvt_pk_bf16(v1[2], v1[3]);
                        *(u32x4*)(zr + col0) = w;
                    }
                }
            }
    }
};
struct Epi3 {
    static constexpr bool PERM = true, AFTER_DRAIN = false;
    const bf16_t* z; bf16_t* P; bf16_t* mb;
    __device__ __forceinline__ void operator()(const f32x4 (&acc)[2][2][4][2], const Unit& u, int wr, int wc, int fr, int fq) const {
        const bool second = u.pm >= 64; const int pm = u.pm & 63, pn = u.pn & 7;
#pragma unroll
        for (int ai = 0; ai < 2; ++ai)
#pragma unroll
            for (int m = 0; m < 4; ++m) {
                const int row = pm * 256 + ai * 128 + wr * 64 + m * 16 + fr;
#pragma unroll
                for (int bj = 0; bj < 2; ++bj) {
                    const int col0 = pn * 256 + bj * 128 + wc * 32 + 8 * fq;
                    float g[8]; unpack8(*(const u32x4*)(z + (size_t)row * DIN + (second ? C_GB : C_GA) + col0), g);
                    float v[8];
#pragma unroll
                    for (int j = 0; j < 4; ++j) { v[j] = acc[ai][bj][m][0][j] * g[j]; v[4 + j] = acc[ai][bj][m][1][j] * g[4 + j]; }
                    if (second) {
                        float p[8]; unpack8(*(const u32x4*)(P + (size_t)row * DM + col0), p);
#pragma unroll
                        for (int j = 0; j < 8; ++j) v[j] += p[j];
                        *(u32x4*)(mb + (size_t)row * DM + col0) = pack8(v);
                    } else {
                        *(u32x4*)(P + (size_t)row * DM + col0) = pack8(v);
                    }
                }
            }
    }
};
struct EpiRes {
    static constexpr bool PERM = true, AFTER_DRAIN = false;
    const float* hin; float* hout; bf16_t* hb; float* ssq;
    __device__ __forceinline__ void operator()(const f32x4 (&acc)[2][2][4][2], const Unit& u, int wr, int wc, int fr, int fq) const {
#pragma unroll
        for (int ai = 0; ai < 2; ++ai)
#pragma unroll
            for (int m = 0; m < 4; ++m) {
                const int row = u.pm * 256 + ai * 128 + wr * 64 + m * 16 + fr;
                float ss = 0.f;
#pragma unroll
                for (int bj = 0; bj < 2; ++bj) {
                    const int col0 = u.pn * 256 + bj * 128 + wc * 32 + 8 * fq;
                    const size_t off = (size_t)row * DM + col0;
                    const f32x4 h0 = *(const f32x4*)(hin + off) + acc[ai][bj][m][0], h1 = *(const f32x4*)(hin + off + 4) + acc[ai][bj][m][1];
                    *(f32x4*)(hout + off) = h0; *(f32x4*)(hout + off + 4) = h1;
                    ss += (h0[0] * h0[0] + h0[1] * h0[1]) + (h0[2] * h0[2] + h0[3] * h0[3]) + (h1[0] * h1[0] + h1[1] * h1[1]) + (h1[2] * h1[2] + h1[3] * h1[3]);
                    if (hb) { u32x4 w; w.x = cvt_pk_bf16(h0[0], h0[1]); w.y = cvt_pk_bf16(h0[2], h0[3]); w.z = cvt_pk_bf16(h1[0], h1[1]); w.w = cvt_pk_bf16(h1[2], h1[3]); *(u32x4*)(hb + off) = w; }
                }
                ss += __shfl_xor(ss, 16); ss += __shfl_xor(ss, 32);
                if (fq == 0) unsafeAtomicAdd(ssq + row, ss);
            }
    }
};
struct Epi5 {
    static constexpr bool PERM = true, AFTER_DRAIN = false;
    bf16_t* ups; const float* ssq2;
    __device__ __forceinline__ void operator()(const f32x4 (&acc)[2][2][4][2], const Unit& u, int wr, int wc, int fr, int fq) const {
#pragma unroll
        for (int ai = 0; ai < 2; ++ai)
#pragma unroll
            for (int m = 0; m < 4; ++m) {
                const int row = u.pm * 256 + ai * 128 + wr * 64 + m * 16 + fr;
                const float rs = 1.0f / sqrtf(ssq2[row] * (1.0f / DM) + EPS);
#pragma unroll
                for (int bj = 0; bj < 2; ++bj) {
                    const int col0 = u.pn * 256 + bj * 128 + wc * 32 + 8 * fq;
                    const f32x4 v0 = acc[ai][bj][m][0] * rs, v1 = acc[ai][bj][m][1] * rs;
                    u32x4 w; w.x = cvt_pk_bf16(v0[0], v0[1]); w.y = cvt_pk_bf16(v0[2], v0[3]); w.z = cvt_pk_bf16(v1[0], v1[1]); w.w = cvt_pk_bf16(v1[2], v1[3]);
                    *(u32x4*)(ups + (size_t)row * (2 * FFH) + col0) = w;
                }
            }
    }
};

enum { RM_ID = 0, RM_WIN = 1, RM_UP = 2 };
template <int RM> __device__ __forceinline__ int rowmap(int n) {
    if (RM == RM_WIN) { if (n >= C_Q && n < C_V) { const int base = n & ~63, d = n & 63; return base + 8 * ((d & 31) >> 2) + 4 * (d >> 5) + (d & 3); } return n; }
    if (RM == RM_UP) { const int isgv = n >= DFF ? 1 : 0; const int cc = n - DFF * isgv; const int half = cc >= FFH ? 1 : 0; const int j = cc - FFH * half; return 2 * FFH * half + FFH * isgv + j; }
    return n;
}
template <int RM> __device__ __forceinline__ void p0_transpose_item(const float* W, const float* gk, int K, int N, bf16_t* WT, int row_off, LAS float* scr, int item, int lane) {
    const int nblk = N / 32, kb = item / nblk, nb = item % nblk, k0 = 64 * kb, n0 = 32 * nb;
#pragma unroll 8
    for (int i = 0; i < 32; ++i) { const int kk = 2 * i + (lane >> 5); float w = W[(size_t)(k0 + kk) * N + n0 + (lane & 31)]; if (gk) w *= gk[k0 + kk]; scr[kk * 33 + (lane & 31)] = w; }
    asm volatile("s_waitcnt lgkmcnt(0)" ::: "memory");
    const int c = lane & 7;
#pragma unroll
    for (int j = 0; j < 4; ++j) { const int n = (lane >> 3) + 8 * j; const LAS float* s = scr + (8 * c) * 33 + n;
        u32x4 o; o.x = cvt_pk_bf16(s[0 * 33], s[1 * 33]); o.y = cvt_pk_bf16(s[2 * 33], s[3 * 33]); o.z = cvt_pk_bf16(s[4 * 33], s[5 * 33]); o.w = cvt_pk_bf16(s[6 * 33], s[7 * 33]);
        *(u32x4*)(WT + (size_t)(row_off + rowmap<RM>(n0 + n)) * K + k0 + 8 * c) = o; }
    asm volatile("s_waitcnt lgkmcnt(0)" ::: "memory");
}

struct Args { const float* in[15]; float* out; unsigned char* ws; int ph_lo, ph_hi; };

__device__ __forceinline__ void phase_prologue(const Args& a, LAS unsigned char* lds, int tid, int lane, int wave, int vcu, int G) {
    unsigned char* ws = a.ws;
    LAS float* scr = (LAS float*)(lds + wave * 16384);
    const int gw = vcu * NWAVES + wave, NGW = G * NWAVES;
    constexpr int I_IN = (DM / 64) * (DIN / 32), I_OA = (DCONV / 64) * (DM / 32), I_OB = (DATT / 64) * (DM / 32), I_MIX = (DM / 64) * (DM / 32), I_UP = (DM / 64) * (2 * DFF / 32), I_DN = (DFF / 64) * (DM / 32);
    constexpr int NITEMS = I_IN + I_OA + I_OB + I_MIX + I_UP + I_DN;
    for (int it = gw; it < NITEMS; it += NGW) {
        int r = it;
        if (r < I_IN) { p0_transpose_item<RM_WIN>(a.in[2], a.in[1], DM, DIN, (bf16_t*)(ws + WS_WIN), 0, scr, r, lane); continue; } r -= I_IN;
        if (r < I_OA) { p0_transpose_item<RM_ID>(a.in[5], nullptr, DCONV, DM, (bf16_t*)(ws + WS_BT3), 0, scr, r, lane); continue; } r -= I_OA;
        if (r < I_OB) { p0_transpose_item<RM_ID>(a.in[7], nullptr, DATT, DM, (bf16_t*)(ws + WS_BT3), DM, scr, r, lane); continue; } r -= I_OB;
        if (r < I_MIX) { p0_transpose_item<RM_ID>(a.in[8], nullptr, DM, DM, (bf16_t*)(ws + WS_WMIX), 0, scr, r, lane); continue; } r -= I_MIX;
        if (r < I_UP) { p0_transpose_item<RM_UP>(a.in[10], a.in[9], DM, 2 * DFF, (bf16_t*)(ws + WS_WUP), 0, scr, r, lane); continue; } r -= I_UP;
        p0_transpose_item<RM_ID>(a.in[13], nullptr, DFF, DM, (bf16_t*)(ws + WS_WDOWN), 0, scr, r, lane);
    }
    const float* x = a.in[0]; bf16_t* xb = (bf16_t*)(ws + WS_XB); float* rstd1 = (float*)(ws + WS_RSTD1);
    for (int m = gw; m < SEQ; m += NGW) {
        const f32x4* xr = (const f32x4*)(x + (size_t)m * DM) + lane; f32x4 v[8]; float s = 0.f;
#pragma unroll
        for (int j = 0; j < 8; ++j) { v[j] = xr[64 * j]; s += (v[j][0] * v[j][0] + v[j][1] * v[j][1]) + (v[j][2] * v[j][2] + v[j][3] * v[j][3]); }
        s = wave_sum(s);
        u32x2* o8 = (u32x2*)(xb + (size_t)m * DM) + lane;
#pragma unroll
        for (int j = 0; j < 8; ++j) { u32x2 w; w.x = cvt_pk_bf16(v[j][0], v[j][1]); w.y = cvt_pk_bf16(v[j][2], v[j][3]); o8[64 * j] = w; }
        if (lane == 0) rstd1[m] = 1.0f / sqrtf(s * (1.0f / DM) + EPS);
    }
    const int gt = vcu * NTHREADS + tid, NGT = G * NTHREADS;
    float* cosT = (float*)(ws + WS_COS); float* sinT = (float*)(ws + WS_SIN);
    for (int idx = gt; idx < SEQ * 32; idx += NGT) {
        const int t = idx >> 5, i = idx & 31;
        double f = 1.0; for (int k = 0; k < i; ++k) f *= 0.7498942093324559;
        const float inv = (float)f; const float angf = (float)t * inv;
        const double ang = (double)angf;
        const double kq = __builtin_rint(ang * 0.6366197723675814);
        double y = __builtin_fma(-kq, 1.5707963267948966, ang); y = __builtin_fma(-kq, 6.123233995736766e-17, y);
        const double y2 = y * y;
        double sp = -1.0 / 1307674368000.0; sp = sp * y2 + 1.0 / 6227020800.0; sp = sp * y2 - 1.0 / 39916800.0; sp = sp * y2 + 1.0 / 362880.0; sp = sp * y2 - 1.0 / 5040.0; sp = sp * y2 + 1.0 / 120.0; sp = sp * y2 - 1.0 / 6.0; sp = sp * y2 + 1.0; sp = sp * y;
        double cp = 1.0 / 20922789888000.0; cp = cp * y2 - 1.0 / 87178291200.0; cp = cp * y2 + 1.0 / 479001600.0; cp = cp * y2 - 1.0 / 3628800.0; cp = cp * y2 + 1.0 / 40320.0; cp = cp * y2 - 1.0 / 720.0; cp = cp * y2 + 1.0 / 24.0; cp = cp * y2 - 0.5; cp = cp * y2 + 1.0;
        const int q = ((int)kq) & 3;
        const double sv = (q == 0) ? sp : (q == 1) ? cp : (q == 2) ? -sp : -cp;
        const double cv = (q == 0) ? cp : (q == 1) ? -sp : (q == 2) ? -cp : sp;
        cosT[idx] = (float)cv; sinT[idx] = (float)sv;
    }
    float* ssq2 = (float*)(ws + WS_SSQ2); float* ssq3 = (float*)(ws + WS_SSQ3);
    for (int idx = gt; idx < SEQ; idx += NGT) { ssq2[idx] = 0.f; ssq3[idx] = 0.f; }
}

__device__ __forceinline__ void load_cv(const bf16_t* z, int t, int c0, float (&cv)[8]) {
    if (t < 0 || t >= SEQ) {
#pragma unroll
        for (int j = 0; j < 8; ++j) cv[j] = 0.f;
        return;
    }
    float c[8], v[8]; unpack8(*(const u32x4*)(z + (size_t)t * DIN + C_CA + c0), c); unpack8(*(const u32x4*)(z + (size_t)t * DIN + C_VA + c0), v);
#pragma unroll
    for (int j = 0; j < 8; ++j) cv[j] = c[j] * v[j];
}
__device__ __forceinline__ void phase_mixer(const Args& a, int lane, int gw, int NGW) {
    const bf16_t* z = (const bf16_t*)(a.ws + WS_Z); bf16_t* ya = (bf16_t*)a.out; const float* cw = a.in[4];
    for (int it = gw; it < (SEQ / 16) * 2; it += NGW) {
        const int t0 = (it >> 1) * 16, c0 = (it & 1) * 512 + 8 * lane;
        float w0[8], w1[8], w2[8];
#pragma unroll
        for (int j = 0; j < 8; ++j) { w0[j] = cw[c0 + j]; w1[j] = cw[DCONV + c0 + j]; w2[j] = cw[2 * DCONV + c0 + j]; }
        float prev[8], cur[8], nxt[8];
        load_cv(z, t0 - 1, c0, prev); load_cv(z, t0, c0, cur);
        for (int t = t0; t < t0 + 16; ++t) {
            load_cv(z, t + 1, c0, nxt);
            float b[8]; unpack8(*(const u32x4*)(z + (size_t)t * DIN + C_BA + c0), b);
            float o[8];
#pragma unroll
            for (int j = 0; j < 8; ++j) { o[j] = b[j] * (w0[j] * prev[j] + w1[j] * cur[j] + w2[j] * nxt[j]); prev[j] = cur[j]; cur[j] = nxt[j]; }
            *(u32x4*)(ya + (size_t)t * DCONV + c0) = pack8(o);
        }
    }
}

constexpr int KROW = 144, VROW = 656, KWIN = 320, LDS_KB = KWIN * KROW;
__device__ __forceinline__ void attn_unit(LAS unsigned char* lds, const bf16_t* z, const bf16_t* vT, bf16_t* att, const float* sink, int kh, int qb, int tid) {
    asm volatile("" : "+v"(tid));
    const int lane = tid & 63, wid = __builtin_amdgcn_readfirstlane(tid >> 6), l31 = lane & 31, hi = lane >> 5;
    const int q0 = qb * 64;
#pragma unroll
    for (int i = 0; i < 5; ++i) {
        const int id = tid + 512 * i, r = id >> 3, ch = id & 7, t = q0 - 128 + r;
        u32x4 v = (u32x4){0u, 0u, 0u, 0u};
        if (t >= 0 && t < SEQ) v = *(const u32x4*)(z + (size_t)t * DIN + C_K + 64 * kh + 8 * ch);
        *(LAS u32x4*)(lds + r * KROW + ch * 16) = v;
    }
#pragma unroll
    for (int i = 0; i < 5; ++i) {
        const int id = tid + 512 * i, d = id / 40, ch = id - d * 40, t = q0 - 128 + 8 * ch;
        u32x4 v = (u32x4){0u, 0u, 0u, 0u};
        if (t >= 0 && t < SEQ) v = *(const u32x4*)(vT + (size_t)(64 * kh + d) * SEQ + t);
        *(LAS u32x4*)(lds + LDS_KB + d * VROW + ch * 16) = v;
    }
    __syncthreads();
    const int g = wid >> 1, sb = wid & 1, head = 4 * kh + g, q0w = q0 + 32 * sb;
    bf16x8 qr[4];
#pragma unroll
    for (int ds = 0; ds < 4; ++ds) qr[ds] = *(const bf16x8*)(z + (size_t)(q0w + l31) * DIN + C_Q + head * 64 + 16 * ds + 8 * hi);
    const int pi = (l31 & 0x13) | ((l31 & 4) << 1) | ((l31 & 8) >> 1);
    f32x16 s[9];
#pragma unroll
    for (int tl = 0; tl < 9; ++tl) {
        const LAS unsigned char* kp = lds + (32 * (sb + tl) + pi) * KROW + 16 * hi;
        f32x16 acc = (f32x16){0.f, 0.f, 0.f, 0.f, 0.f, 0.f, 0.f, 0.f, 0.f, 0.f, 0.f, 0.f, 0.f, 0.f, 0.f, 0.f};
#pragma unroll
        for (int ds = 0; ds < 4; ++ds) { const bf16x8 kf = *(const LAS bf16x8*)(kp + 32 * ds); acc = __builtin_amdgcn_mfma_f32_32x32x16_bf16(kf, qr[ds], acc, 0, 0, 0); }
        s[tl] = acc;
    }
    const float sinkl = sink[head] * LOG2E;
    float mx = sinkl;
    const int qpos = q0w + l31;
#pragma unroll
    for (int tl = 0; tl < 9; ++tl)
#pragma unroll
        for (int r = 0; r < 16; ++r) {
            const int kpos = q0w - 128 + 32 * tl + 16 * (r >> 3) + 8 * hi + (r & 7);
            const int dlt = kpos - qpos;
            const bool ok = (dlt >= -128) && (dlt <= 128) && (kpos >= 0) && (kpos < SEQ);
            const float v = ok ? s[tl][r] : -INFINITY;
            s[tl][r] = v; mx = fmaxf(mx, v);
        }
    mx = fmaxf(mx, __shfl_xor(mx, 32));
    float sum = 0.f;
#pragma unroll
    for (int tl = 0; tl < 9; ++tl)
#pragma unroll
        for (int r = 0; r < 16; ++r) { const float p = __builtin_amdgcn_exp2f(s[tl][r] - mx); s[tl][r] = p; sum += p; }
    sum += __shfl_xor(sum, 32);
    const float inv = 1.0f / (sum + __builtin_amdgcn_exp2f(sinkl - mx));
    f32x16 o[2];
    o[0] = (f32x16){0.f, 0.f, 0.f, 0.f, 0.f, 0.f, 0.f, 0.f, 0.f, 0.f, 0.f, 0.f, 0.f, 0.f, 0.f, 0.f}; o[1] = o[0];
#pragma unroll
    for (int tl = 0; tl < 9; ++tl)
#pragma unroll
        for (int s2 = 0; s2 < 2; ++s2) {
            u32x4 pw; pw.x = cvt_pk_bf16(s[tl][8 * s2 + 0], s[tl][8 * s2 + 1]); pw.y = cvt_pk_bf16(s[tl][8 * s2 + 2], s[tl][8 * s2 + 3]);
            pw.z = cvt_pk_bf16(s[tl][8 * s2 + 4], s[tl][8 * s2 + 5]); pw.w = cvt_pk_bf16(s[tl][8 * s2 + 6], s[tl][8 * s2 + 7]);
            const bf16x8 pb = __builtin_bit_cast(bf16x8, pw);
#pragma unroll
            for (int db = 0; db < 2; ++db) {
                const bf16x8 vf = *(const LAS bf16x8*)(lds + LDS_KB + (32 * db + l31) * VROW + (32 * (sb + tl) + 16 * s2 + 8 * hi) * 2);
                o[db] = __builtin_amdgcn_mfma_f32_32x32x16_bf16(vf, pb, o[db], 0, 0, 0);
            }
        }
    bf16_t* orow = att + (size_t)(q0w + l31) * DATT + head * 64;
#pragma unroll
    for (int db = 0; db < 2; ++db)
#pragma unroll
        for (int rg = 0; rg < 4; ++rg) {
            u32x2 w; w.x = cvt_pk_bf16(o[db][4 * rg + 0] * inv, o[db][4 * rg + 1] * inv); w.y = cvt_pk_bf16(o[db][4 * rg + 2] * inv, o[db][4 * rg + 3] * inv);
            *(u32x2*)(orow + 32 * db + 8 * rg + 4 * hi) = w;
        }
    __syncthreads();
}

__device__ __forceinline__ void load_up(const bf16_t* ups, int t, int j0, float (&ua)[8], float (&ug)[8]) {
    if (t < 0 || t >= SEQ) {
#pragma unroll
        for (int j = 0; j < 8; ++j) { ua[j] = 0.f; ug[j] = 0.f; }
        return;
    }
    unpack8(*(const u32x4*)(ups + (size_t)t * (2 * FFH) + j0), ua); unpack8(*(const u32x4*)(ups + (size_t)t * (2 * FFH) + FFH + j0), ug);
}
__device__ __forceinline__ void phase_ffnconv(const Args& a, int half, int lane, int gw, int NGW) {
    const bf16_t* ups = (const bf16_t*)(a.ws + WS_UPS); bf16_t* act = (bf16_t*)(a.ws + WS_ACT); const float* cw = a.in[11]; const float* cb = a.in[12];
    for (int it = gw; it < (SEQ / 16) * 6; it += NGW) {
        const int run = it / 6, cg6 = it - run * 6, chunk = 64 * cg6 + lane, t0 = run * 16;
        if (chunk >= FFH / 8) continue;
        const int j0 = 8 * chunk, ca = FFH * half + j0;
        float wa0[8], wa1[8], wa2[8], ba[8], wg0[8], wg1[8], wg2[8], bg[8];
#pragma unroll
        for (int j = 0; j < 8; ++j) {
            wa0[j] = cw[ca + j]; wa1[j] = cw[2 * DFF + ca + j]; wa2[j] = cw[4 * DFF + ca + j]; ba[j] = cb[ca + j];
            wg0[j] = cw[DFF + ca + j]; wg1[j] = cw[3 * DFF + ca + j]; wg2[j] = cw[5 * DFF + ca + j]; bg[j] = cb[DFF + ca + j];
        }
        float pa_[8], pg_[8], ca_[8], cg_[8], na_[8], ng_[8];
        load_up(ups, t0 - 1, j0, pa_, pg_); load_up(ups, t0, j0, ca_, cg_);
        for (int t = t0; t < t0 + 16; ++t) {
            load_up(ups, t + 1, j0, na_, ng_);
            float o[8];
#pragma unroll
            for (int j = 0; j < 8; ++j) {
                const float A = wa0[j] * pa_[j] + wa1[j] * ca_[j] + wa2[j] * na_[j] + ba[j];
                const float Gv = wg0[j] * pg_[j] + wg1[j] * cg_[j] + wg2[j] * ng_[j] + bg[j];
                o[j] = A * sigmoidf_(A) * Gv;
                pa_[j] = ca_[j]; ca_[j] = na_[j]; pg_[j] = cg_[j]; cg_[j] = ng_[j];
            }
            *(u32x4*)(act + (size_t)t * DFF + ca) = pack8(o);
        }
    }
}

constexpr size_t WS_BAR = 196608 + 256;
__device__ __forceinline__ void grid_barrier(unsigned* cnt, unsigned target) {
    asm volatile("s_waitcnt vmcnt(0)" ::: "memory");
    __syncthreads();
    if (threadIdx.x == 0) {
        __builtin_amdgcn_fence(__ATOMIC_RELEASE, "agent");
        asm volatile("s_waitcnt vmcnt(0)" ::: "memory");
        __hip_atomic_fetch_add(cnt, 1u, __ATOMIC_RELAXED, __HIP_MEMORY_SCOPE_AGENT);
        while (__hip_atomic_load(cnt, __ATOMIC_RELAXED, __HIP_MEMORY_SCOPE_AGENT) < target) __builtin_amdgcn_s_sleep(2);
        __builtin_amdgcn_fence(__ATOMIC_ACQUIRE, "agent");
        asm volatile("s_waitcnt vmcnt(0)" ::: "memory");
    }
    __syncthreads();
}

__global__ void __launch_bounds__(NTHREADS, 2) fwd_megakernel(Args args) {
    extern __shared__ __attribute__((aligned(16))) unsigned char lds_raw[];
    LAS unsigned char* lds = (LAS unsigned char*)lds_raw;
    const int tid = threadIdx.x, lane = tid & 63, wave = __builtin_amdgcn_readfirstlane(tid >> 6);
    const int G = gridDim.x, bx = blockIdx.x;
    const int vcu = (G % 8 == 0) ? (bx % 8) * (G / 8) + bx / 8 : bx;
    const int gw = vcu * NWAVES + wave, NGW = G * NWAVES;
    unsigned char* ws = args.ws;
    const int lo = args.ph_lo, hi = args.ph_hi;
#define IN(k) (lo <= (k) && (k) < hi)
    unsigned* barw = (unsigned*)(ws + WS_BAR); unsigned nbar = 0;
#define SEAM(k) do { if (IN(k) && IN((k) + 1)) { nbar += (unsigned)G; grid_barrier(barw, nbar); } } while (0)

    if (IN(0)) {
        if (bx == 0 && tid == 0) __hip_atomic_store(barw, 0u, __ATOMIC_RELAXED, __HIP_MEMORY_SCOPE_AGENT);
        phase_prologue(args, lds, tid, lane, wave, vcu, G);
    }
    if (IN(0) && IN(1)) { cg::this_grid().sync(); }
    if (IN(1)) {
        Gemm g{(const bf16_t*)(ws + WS_XB), (const bf16_t*)(ws + WS_WIN), SEQ, DIN, DM}; Sched1 S; S.init(G, bx);
        Epi1 E{(bf16_t*)(ws + WS_Z), (bf16_t*)(ws + WS_VT), (const float*)(ws + WS_RSTD1), (const float*)(ws + WS_COS), (const float*)(ws + WS_SIN), args.in[3]};
        pg8::gemm_phase<Epi1, Sched1, true, true>(lds, g, S, E);
    }
    SEAM(1);
    if (IN(2)) {
        phase_mixer(args, lane, gw, NGW);
        const bf16_t* z = (const bf16_t*)(ws + WS_Z); const bf16_t* vT = (const bf16_t*)(ws + WS_VT); bf16_t* att = (bf16_t*)args.out + (size_t)SEQ * DCONV;
        for (int u = vcu; u < NKV * (SEQ / 64); u += G) attn_unit(lds, z, vT, att, args.in[6], u & 3, u >> 2, tid);
    }
    SEAM(2);
    if (IN(3)) {
        Gemm g{(const bf16_t*)args.out, (const bf16_t*)(ws + WS_BT3), 2 * SEQ, 2 * DM, DCONV}; Sched3 S; S.init(G, bx);
        Epi3 E{(const bf16_t*)(ws + WS_Z), (bf16_t*)args.out + (size_t)2 * SEQ * DCONV, (bf16_t*)(ws + WS_MB)};
        pg8::gemm_phase<Epi3, Sched3, true, true>(lds, g, S, E);
    }
    SEAM(3);
    if (IN(4)) {
        Gemm g{(const bf16_t*)(ws + WS_MB), (const bf16_t*)(ws + WS_WMIX), SEQ, DM, DM}; pg8::StaticOrder S; S.init(SEQ, DM, G, bx);
        EpiRes E{args.in[0], args.out, (bf16_t*)(ws + WS_H1B), (float*)(ws + WS_SSQ2)};
        pg8::gemm_phase<EpiRes, pg8::StaticOrder, true, true>(lds, g, S, E);
    }
    SEAM(4);
#pragma unroll 1
    for (int half = 0; half < 2; ++half) {
        if (IN(5 + 2 * half)) {
            Gemm g{(const bf16_t*)(ws + WS_H1B), (const bf16_t*)(ws + WS_WUP) + (size_t)half * (2 * FFH) * DM, SEQ, 2 * FFH, DM}; pg8::StaticOrder S; S.init(SEQ, 2 * FFH, G, bx);
            Epi5 E{(bf16_t*)(ws + WS_UPS), (const float*)(ws + WS_SSQ2)};
            pg8::gemm_phase<Epi5, pg8::StaticOrder, true, true>(lds, g, S, E);
        }
        SEAM(5 + 2 * half);
        if (IN(6 + 2 * half)) { phase_ffnconv(args, half, lane, gw, NGW); }
        SEAM(6 + 2 * half);
    }
    if (IN(9)) {
        Gemm g{(const bf16_t*)(ws + WS_ACT), (const bf16_t*)(ws + WS_WDOWN), SEQ, DM, DFF}; pg8::StaticOrder S; S.init(SEQ, DM, G, bx);
        EpiRes E{args.out, args.out, nullptr, (float*)(ws + WS_SSQ3)};
        pg8::gemm_phase<EpiRes, pg8::StaticOrder, true, true>(lds, g, S, E);
    }
    SEAM(9);
    if (IN(10)) {
        const float* ssq3 = (const float*)(ws + WS_SSQ3); const float* gf = args.in[14];
        for (int m = gw; m < SEQ; m += NGW) {
            const float rs = 1.0f / sqrtf(ssq3[m] * (1.0f / DM) + EPS);
            f32x4* xr = (f32x4*)(args.out + (size_t)m * DM) + lane; const f32x4* gr = (const f32x4*)gf + lane;
#pragma unroll
            for (int j = 0; j < 8; ++j) { const f32x4 v = xr[64 * j] * rs * gr[64 * j]; xr[64 * j] = v; }
        }
    }
#undef IN
#undef SEAM
}

constexpr int N_PHASES = 11;
extern "C" void kernel_launch(void* const* d_in, const int* in_sizes, int n_in, void* d_out, int out_size, void* d_ws, size_t ws_size, hipStream_t stream) {
    static int grid = 0;
    if (grid == 0) {
        if (n_in != 15 || in_sizes[0] != SEQ * DM || out_size != SEQ * DM || ws_size < WS_END) { fprintf(stderr, "kernel_launch: unexpected shapes / workspace (n_in %d, in0 %d, out %d, ws %zu)\n", n_in, n_in > 0 ? in_sizes[0] : -1, out_size, ws_size); grid = -1; return; }
        int dev = 0, cus = 0;
        if (hipGetDevice(&dev) != hipSuccess || hipDeviceGetAttribute(&cus, hipDeviceAttributeMultiprocessorCount, dev) != hipSuccess) { grid = -1; return; }
        if (hipFuncSetAttribute((const void*)fwd_megakernel, hipFuncAttributeMaxDynamicSharedMemorySize, LDS_BYTES) != hipSuccess) { fprintf(stderr, "kernel_launch: hipFuncSetAttribute failed\n"); grid = -1; return; }
        int per_cu = 0;
        if (hipOccupancyMaxActiveBlocksPerMultiprocessor(&per_cu, (const void*)fwd_megakernel, NTHREADS, LDS_BYTES) != hipSuccess || per_cu < 1) { fprintf(stderr, "kernel_launch: occupancy query says %d blocks per CU\n", per_cu); (void)hipGetLastError(); }
        grid = cus;
    }
    if (grid < 0) return;
    Args a{};
    for (int i = 0; i < 15; ++i) a.in[i] = (const float*)d_in[i];
    a.out = (float*)d_out; a.ws = (unsigned char*)d_ws;
#if MK_N_LAUNCHES == 1
    a.ph_lo = 0; a.ph_hi = N_PHASES;
    void* kargs[] = {&a};
    hipError_t e = hipLaunchCooperativeKernel((const void*)fwd_megakernel, dim3(grid), dim3(NTHREADS), kargs, LDS_BYTES, stream);
    if (e != hipSuccess) fprintf(stderr, "kernel_launch: cooperative launch failed: %s (grid %d)\n", hipGetErrorString(e), grid);
#else
    for (int ph = 0; ph < N_PHASES; ++ph) {
        a.ph_lo = ph; a.ph_hi = ph + 1;
        hipLaunchKernelGGL(fwd_megakernel, dim3(grid), dim3(NTHREADS), LDS_BYTES, stream, a);
    }
#endif
}
```

```cpp
#include <hip/hip_runtime.h>
#include <hip/hip_cooperative_groups.h>
#include <cstdio>
#include <cstdint>
namespace cg = cooperative_groups;
#ifndef MK_N_LAUNCHES
#define MK_N_LAUNCHES 1
#endif
namespace pg8 {
#define PG8_LAS __attribute__((address_space(3)))
typedef unsigned short bf16_t;
typedef short bf16x8 __attribute__((ext_vector_type(8)));
typedef float f32x4 __attribute__((ext_vector_type(4)));
typedef unsigned u32x4 __attribute__((ext_vector_type(4)));
constexpr int BM = 256, BK = 64, HALF = 128, HTB = HALF * BK * 2  , STAGE_BYTES = 8 * HTB, NXCD = 8, WGM = 8;

__host__ __device__ __forceinline__ int lds_byte(int r, int c) { const int st = (r >> 4) * 2 + (c >> 5), rr = r & 15, cc = c & 31, ob = rr * 64 + cc * 2; return st * 1024 + (ob ^ (((ob >> 9) & 1) << 5)); }
__host__ __device__ __forceinline__ void stage_rc(int b, int& R, int& C) { const int st = b / 1024, sb = b % 1024, swz = sb ^ (((sb >> 9) & 1) << 5); R = (st >> 1) * 16 + swz / 64; C = (st & 1) * 32 + (swz % 64) / 2; }
__host__ __device__ __forceinline__ int perm32(int rho) { const int n = rho >> 4, i = rho & 15; return 8 * (i >> 2) + 4 * n + (i & 3); }

struct Unit { int pm, pn; };
struct Gemm { const bf16_t* A; const bf16_t* Bt; int M, N, K; };

struct StaticOrder {
    int nM, nN, nwg, G, c;
    __host__ __device__ void init(int M, int N, int G_, int c_) { nM = M / BM; nN = N / BM; nwg = nM * nN; G = G_; c = c_; }
    __host__ __device__ bool next(int i, Unit& u) const {
        const long L = (long)i * G + c; if (L >= nwg) return false;
        int wgid = (int)L; { const int q = nwg / NXCD, r = nwg % NXCD, xcd = wgid % NXCD, off = wgid / NXCD; wgid = (xcd < r ? xcd * (q + 1) : r * (q + 1) + (xcd - r) * q) + off; }
        const int nig = WGM * nN, gid = wgid / nig, fm = gid * WGM, gsz = (nM - fm) < WGM ? (nM - fm) : WGM;
        u.pm = fm + ((wgid % nig) % gsz); u.pn = (wgid % nig) / gsz; return true;
    }
    __device__ __forceinline__ const char* pa(const Gemm& g, const Unit& u, size_t tstep) const { return (const char*)g.A + (size_t)u.pm * tstep; }
    __device__ __forceinline__ const char* pb(const Gemm& g, const Unit& u, size_t tstep) const { return (const char*)g.Bt + (size_t)u.pn * tstep; }
    __device__ __forceinline__ void a_ready(const Unit&) const {}
    __device__ __forceinline__ void done(const Unit&) const {}
};

__device__ __forceinline__ unsigned cvt_pk_bf16(float lo, float hi) { unsigned r; asm volatile("v_cvt_pk_bf16_f32 %0, %1, %2" : "=v"(r) : "v"(lo), "v"(hi)); return r; }
typedef float f32x2 __attribute__((ext_vector_type(2)));
template <class Epi, class Sched, bool ALIGN_EPI = false, bool SP2 = false>
__device__ __forceinline__ void gemm_phase(PG8_LAS unsigned char* lds, const Gemm g, const Sched& S, const Epi& E) {
    const int tid = threadIdx.x, wid = __builtin_amdgcn_readfirstlane(tid >> 6), lane = tid & 63, wr = wid >> 2, wc = wid & 3, fr = lane & 15, fq = lane >> 4;
    const int K = g.K, nt = K / BK;
    unsigned voffA[2], voffB[2];
#pragma unroll
    for (int i = 0; i < 2; ++i) { int R, C; stage_rc(tid * 16 + i * 8192, R, C); const int Rb = Epi::PERM ? ((R & ~31) + perm32(R & 31)) : R;
        voffA[i] = (unsigned)(R * K + C) * 2u; voffB[i] = (unsigned)(Rb * K + C) * 2u; }
    const size_t kstep = (size_t)(BK * 2);
    const size_t hstep = (size_t)HALF * K * 2;
    const size_t tstep = 2 * hstep;
    const unsigned ldsw = (unsigned)wid * 1024u;
    const int aoff = lds_byte(wr * 64 + fr, fq * 8), boff = lds_byte(wc * 32 + fr, fq * 8);
#define PG8_SA(b, h) (((b) * 2 + (h)) * HTB)
#define PG8_SB(b, h) ((4 + (b) * 2 + (h)) * HTB)
#define PG8_STAGE(bufoff, gbase, voff) do { _Pragma("unroll") for (int _i = 0; _i < 2; ++_i) \
        __builtin_amdgcn_global_load_lds((const unsigned*)((const char*)(gbase) + (voff)[_i]), (PG8_LAS unsigned*)(lds + (bufoff) + ldsw + _i * 8192), 16, 0, 0); } while (0)
#define PG8_LDA(dst, b, h) do { _Pragma("unroll") for (int m = 0; m < 4; ++m) _Pragma("unroll") for (int k = 0; k < 2; ++k) dst[m][k] = *(const PG8_LAS bf16x8*)(lds + PG8_SA(b, h) + aoff + m * 2048 + k * 1024); } while (0)
#define PG8_LDB(dst, b, h) do { _Pragma("unroll") for (int n = 0; n < 2; ++n) _Pragma("unroll") for (int k = 0; k < 2; ++k) dst[n][k] = *(const PG8_LAS bf16x8*)(lds + PG8_SB(b, h) + boff + n * 2048 + k * 1024); } while (0)
#define PG8_MMA(ai, bj, At, Bt) do { __builtin_amdgcn_s_setprio(1); _Pragma("unroll") for (int m = 0; m < 4; ++m) _Pragma("unroll") for (int n = 0; n < 2; ++n) _Pragma("unroll") for (int k = 0; k < 2; ++k) \
        acc[ai][bj][m][n] = __builtin_amdgcn_mfma_f32_16x16x32_bf16(Bt[n][k], At[m][k], acc[ai][bj][m][n], 0, 0, 0); __builtin_amdgcn_s_setprio(0); } while (0)
#define PG8_WAIT_V(n) asm volatile("s_waitcnt vmcnt(" #n ")" ::: "memory")
#define PG8_WAIT_L(n) asm volatile("s_waitcnt lgkmcnt(" #n ")" ::: "memory")
#define PG8_BAR __builtin_amdgcn_s_barrier()
#define PG8_SCHED __builtin_amdgcn_sched_barrier(0)
    Unit cur, nxt; int ui = 0;
    if (!S.next(0, cur)) return;
    f32x4 acc[2][2][4][2];
#pragma unroll
    for (int a = 0; a < 2; ++a)
#pragma unroll
        for (int b = 0; b < 2; ++b)
#pragma unroll
            for (int m = 0; m < 4; ++m)
#pragma unroll
                for (int n = 0; n < 2; ++n) acc[a][b][m][n] = (f32x4){0.f, 0.f, 0.f, 0.f};
    bf16x8 At[4][2], B0[2][2], B1[2][2];
    const char* cA = S.pa(g, cur, tstep); const char* cB = S.pb(g, cur, tstep);
    S.a_ready(cur);
    if constexpr (SP2) {
        PG8_STAGE(PG8_SB(0, 0), cB, voffB); PG8_STAGE(PG8_SB(0, 1), cB + hstep, voffB); PG8_STAGE(PG8_SA(0, 0), cA, voffA); PG8_STAGE(PG8_SA(0, 1), cA + hstep, voffA);
        if (wr == 1) PG8_BAR;
        PG8_WAIT_V(2); PG8_BAR;
        PG8_STAGE(PG8_SB(1, 0), cB + kstep, voffB); PG8_STAGE(PG8_SA(1, 0), cA + kstep, voffA); PG8_STAGE(PG8_SB(1, 1), cB + hstep + kstep, voffB);
        PG8_WAIT_V(6); PG8_BAR;
    } else {
        PG8_STAGE(PG8_SB(0, 0), cB, voffB); PG8_STAGE(PG8_SA(0, 0), cA, voffA); PG8_STAGE(PG8_SB(0, 1), cB + hstep, voffB); PG8_STAGE(PG8_SA(0, 1), cA + hstep, voffA);
        if (wr == 1) PG8_BAR;
        PG8_WAIT_V(4); PG8_BAR;
        PG8_STAGE(PG8_SB(1, 0), cB + kstep, voffB); PG8_STAGE(PG8_SA(1, 0), cA + kstep, voffA); PG8_STAGE(PG8_SB(1, 1), cB + hstep + kstep, voffB);
        PG8_WAIT_V(6); PG8_BAR;
    }
    for (;;) {
        const bool has_next = S.next(ui + 1, nxt);
        const char* nA = has_next ? S.pa(g, nxt, tstep) : cA; const char* nB = has_next ? S.pb(g, nxt, tstep) : cB;
        for (int t = 0; t < nt; t += 2) {
            const bool last = (t == nt - 2);
            const char* a1 = cA + (size_t)(t + 1) * kstep;
            const char* a2 = last ? nA : cA + (size_t)(t + 2) * kstep; const char* b2 = last ? nB : cB + (size_t)(t + 2) * kstep;
            const char* a3 = a2 + kstep; const char* b3 = b2 + kstep;
            if (last && has_next) S.a_ready(nxt);
            if constexpr (SP2) {
            PG8_LDB(B0, 0, 0); PG8_LDB(B1, 0, 1); PG8_SCHED; PG8_LDA(At, 0, 0); PG8_STAGE(PG8_SA(1, 1), a1 + hstep, voffA);
            PG8_WAIT_V(8); PG8_WAIT_L(0); PG8_BAR; PG8_MMA(0, 0, At, B0); PG8_MMA(0, 1, At, B1); PG8_BAR; PG8_SCHED;
            PG8_LDA(At, 0, 1); PG8_STAGE(PG8_SB(0, 0), b2, voffB); PG8_STAGE(PG8_SB(0, 1), b2 + hstep, voffB); PG8_STAGE(PG8_SA(0, 0), a2, voffA);
            PG8_WAIT_V(8); PG8_WAIT_L(0); PG8_BAR; PG8_MMA(1, 0, At, B0); PG8_MMA(1, 1, At, B1); PG8_BAR; PG8_SCHED;
            PG8_LDB(B0, 1, 0); PG8_LDB(B1, 1, 1); PG8_SCHED; PG8_LDA(At, 1, 0); PG8_STAGE(PG8_SA(0, 1), a2 + hstep, voffA);
            PG8_WAIT_V(8); PG8_WAIT_L(0); PG8_BAR; PG8_MMA(0, 0, At, B0); PG8_MMA(0, 1, At, B1); PG8_BAR; PG8_SCHED;
            PG8_LDA(At, 1, 1); PG8_STAGE(PG8_SB(1, 0), b3, voffB); PG8_STAGE(PG8_SB(1, 1), b3 + hstep, voffB); PG8_STAGE(PG8_SA(1, 0), a3, voffA);
            PG8_WAIT_V(8); PG8_WAIT_L(0); PG8_BAR; PG8_MMA(1, 0, At, B0); PG8_MMA(1, 1, At, B1); PG8_BAR; PG8_SCHED;
            } else {
            PG8_LDB(B0, 0, 0); PG8_SCHED; PG8_LDA(At, 0, 0); PG8_STAGE(PG8_SA(1, 1), a1 + hstep, voffA);
            PG8_WAIT_L(8); PG8_BAR; PG8_WAIT_L(0); PG8_MMA(0, 0, At, B0); PG8_BAR; PG8_SCHED;
            PG8_LDB(B1, 0, 1); PG8_STAGE(PG8_SB(0, 0), b2, voffB);
            PG8_BAR; PG8_WAIT_L(0); PG8_MMA(0, 1, At, B1); PG8_BAR;
            PG8_LDA(At, 0, 1); PG8_STAGE(PG8_SA(0, 0), a2, voffA);
            PG8_BAR; PG8_WAIT_L(0); PG8_MMA(1, 0, At, B0); PG8_BAR; PG8_SCHED;
            PG8_STAGE(PG8_SB(0, 1), b2 + hstep, voffB);
            PG8_WAIT_V(6); PG8_BAR; PG8_MMA(1, 1, At, B1); PG8_BAR;
            PG8_LDB(B0, 1, 0); PG8_SCHED; PG8_LDA(At, 1, 0); PG8_STAGE(PG8_SA(0, 1), a2 + hstep, voffA);
            PG8_WAIT_L(8); PG8_BAR; PG8_WAIT_L(0); PG8_MMA(0, 0, At, B0); PG8_BAR; PG8_SCHED;
            PG8_LDB(B1, 1, 1); PG8_STAGE(PG8_SB(1, 0), b3, voffB);
            PG8_BAR; PG8_WAIT_L(0); PG8_MMA(0, 1, At, B1); PG8_BAR;
            PG8_LDA(At, 1, 1); PG8_STAGE(PG8_SA(1, 0), a3, voffA);
            PG8_BAR; PG8_WAIT_L(0); PG8_MMA(1, 0, At, B0); PG8_BAR; PG8_SCHED;
            PG8_STAGE(PG8_SB(1, 1), b3 + hstep, voffB);
            PG8_WAIT_V(6); PG8_BAR; PG8_MMA(1, 1, At, B1); PG8_BAR;
            }
        }
        if constexpr (ALIGN_EPI) { if (wr == 0) PG8_BAR; }
        if constexpr (!Epi::AFTER_DRAIN) { E(acc, cur, wr, wc, fr, fq); S.done(cur); }
        if (!has_next) break;
#pragma unroll
        for (int a = 0; a < 2; ++a)
#pragma unroll
            for (int b = 0; b < 2; ++b)
#pragma unroll
                for (int m = 0; m < 4; ++m)
#pragma unroll
                    for (int n = 0; n < 2; ++n) acc[a][b][m][n] = (f32x4){0.f, 0.f, 0.f, 0.f};
        cur = nxt; cA = nA; cB = nB; ++ui;
        if constexpr (ALIGN_EPI) { if (wr == 1) PG8_BAR; }
    }
    PG8_WAIT_V(0);
    if constexpr (!ALIGN_EPI) { if (wr == 0) PG8_BAR; }
    PG8_BAR;
    if constexpr (Epi::AFTER_DRAIN) { E.fused(acc, cur, wr, wc, fr, fq, lds, wid, lane); S.done(cur); }
#undef PG8_SA
#undef PG8_SB
#undef PG8_STAGE
#undef PG8_LDA
#undef PG8_LDB
#undef PG8_MMA
#undef PG8_WAIT_V
#undef PG8_WAIT_L
#undef PG8_BAR
#undef PG8_SCHED
}
}

using pg8::bf16_t; using pg8::bf16x8; using pg8::f32x4; using pg8::u32x4; using pg8::cvt_pk_bf16; using pg8::Unit; using pg8::Gemm;
#define LAS __attribute__((address_space(3)))
typedef float f32x16 __attribute__((ext_vector_type(16)));
typedef unsigned u32x2 __attribute__((ext_vector_type(2)));
constexpr int SEQ = 16384, DM = 2048, DCONV = 1024, NH = 16, NKV = 4, HD = 64, DATT = 1024, DFF = 5632, FFH = 2816;
constexpr int DIN = 8704;
constexpr int C_BA = 0, C_CA = 1024, C_VA = 2048, C_Q = 3072, C_K = 4096, C_V = 4352, C_GA = 4608, C_GB = 6656;
constexpr float EPS = 1e-6f;
constexpr float LOG2E = 1.4426950408889634f;
constexpr float QSCALE = 0.125f * 1.4426950408889634f;
constexpr int NWAVES = 8, NTHREADS = 512;
constexpr int LDS_BYTES = 147456;

constexpr size_t MiB = (size_t)1 << 20;
constexpr size_t WS_SSQ2 = 0, WS_SSQ3 = 65536, WS_RSTD1 = 131072;
constexpr size_t WS_COS = 1 * MiB, WS_SIN = 3 * MiB;
constexpr size_t WS_WUP = 6 * MiB, WS_WDOWN = 50 * MiB;
constexpr size_t WS_Z = 72 * MiB;
constexpr size_t WS_H1B = 72 * MiB;
constexpr size_t WS_VT = 344 * MiB;
constexpr size_t WS_XB = 352 * MiB, WS_MB = 352 * MiB;
constexpr size_t WS_WIN = 416 * MiB, WS_BT3 = 450 * MiB, WS_WMIX = 458 * MiB;
constexpr size_t WS_UPS = 136 * MiB;
constexpr size_t WS_ACT = 312 * MiB;
constexpr size_t WS_END = 488 * MiB;

__device__ __forceinline__ void unpack8(const u32x4 w, float (&f)[8]) {
    f[0] = __uint_as_float(w.x << 16); f[1] = __uint_as_float(w.x & 0xffff0000u);
    f[2] = __uint_as_float(w.y << 16); f[3] = __uint_as_float(w.y & 0xffff0000u);
    f[4] = __uint_as_float(w.z << 16); f[5] = __uint_as_float(w.z & 0xffff0000u);
    f[6] = __uint_as_float(w.w << 16); f[7] = __uint_as_float(w.w & 0xffff0000u);
}
__device__ __forceinline__ u32x4 pack8(const float (&f)[8]) {
    u32x4 w; w.x = cvt_pk_bf16(f[0], f[1]); w.y = cvt_pk_bf16(f[2], f[3]); w.z = cvt_pk_bf16(f[4], f[5]); w.w = cvt_pk_bf16(f[6], f[7]); return w;
}
__device__ __forceinline__ float sigmoidf_(float v) { return __builtin_amdgcn_rcpf(1.0f + __builtin_amdgcn_exp2f(-v * LOG2E)); }
__device__ __forceinline__ float wave_sum(float v) {
#pragma unroll
    for (int o = 1; o < 64; o <<= 1) v += __shfl_xor(v, o);
    return v;
}

struct Sched1 {
    pg8::StaticOrder so;
    __device__ void init(int G, int c) { so.init(SEQ, DIN, G, c); }
    __device__ bool next(int i, Unit& u) const { return so.next(i, u); }
    __device__ __forceinline__ const char* pa(const Gemm& g, const Unit& u, size_t tstep) const { return u.pn == 17 ? (const char*)g.Bt + (size_t)17 * tstep : (const char*)g.A + (size_t)u.pm * tstep; }
    __device__ __forceinline__ const char* pb(const Gemm& g, const Unit& u, size_t tstep) const { return u.pn == 17 ? (const char*)g.A + (size_t)u.pm * tstep : (const char*)g.Bt + (size_t)u.pn * tstep; }
    __device__ __forceinline__ void a_ready(const Unit&) const {}
    __device__ __forceinline__ void done(const Unit&) const {}
};
struct Sched3 {
    pg8::StaticOrder so;
    __device__ void init(int G, int c) { so.init(SEQ, DM, G, c); }
    __device__ bool next(int i, Unit& u) const { if (!so.next(i >> 1, u)) return false; if (i & 1) { u.pm += 64; u.pn += 8; } return true; }
    __device__ __forceinline__ const char* pa(const Gemm& g, const Unit& u, size_t tstep) const { return (const char*)g.A + (size_t)u.pm * tstep; }
    __device__ __forceinline__ const char* pb(const Gemm& g, const Unit& u, size_t tstep) const { return (const char*)g.Bt + (size_t)u.pn * tstep; }
    __device__ __forceinline__ void a_ready(const Unit&) const {}
    __device__ __forceinline__ void done(const Unit&) const {}
};

struct Epi1 {
    static constexpr bool PERM = true, AFTER_DRAIN = false;
    bf16_t* z; bf16_t* vT; const float* rstd1; const float* cosT; const float* sinT; const float* bgate;
    __device__ __forceinline__ void operator()(const f32x4 (&acc)[2][2][4][2], const Unit& u, int wr, int wc, int fr, int fq) const {
        if (u.pn == 17) {
#pragma unroll
            for (int bj = 0; bj < 2; ++bj) {
                const int tok0 = u.pm * 256 + bj * 128 + wc * 32 + 8 * fq;
                const f32x4 r0 = *(const f32x4*)(rstd1 + tok0), r1 = *(const f32x4*)(rstd1 + tok0 + 4);
#pragma unroll
                for (int ai = 0; ai < 2; ++ai)
#pragma unroll
                    for (int m = 0; m < 4; ++m) {
                        const int d = ai * 128 + wr * 64 + m * 16 + fr;
                        const f32x4 v0 = acc[ai][bj][m][0] * r0, v1 = acc[ai][bj][m][1] * r1;
                        u32x4 w; w.x = cvt_pk_bf16(v0[0], v0[1]); w.y = cvt_pk_bf16(v0[2], v0[3]); w.z = cvt_pk_bf16(v1[0], v1[1]); w.w = cvt_pk_bf16(v1[2], v1[3]);
                        *(u32x4*)(vT + (size_t)d * SEQ + tok0) = w;
                    }
            }
            return;
        }
        const int kind = u.pn < 12 ? 0 : (u.pn < 17 ? 1 : 2);
#pragma unroll
        for (int ai = 0; ai < 2; ++ai)
#pragma unroll
            for (int m = 0; m < 4; ++m) {
                const int row = u.pm * 256 + ai * 128 + wr * 64 + m * 16 + fr;
                const float rs = rstd1[row];
                bf16_t* zr = z + (size_t)row * DIN;
#pragma unroll
                for (int bj = 0; bj < 2; ++bj) {
                    const int col0 = u.pn * 256 + bj * 128 + wc * 32 + 8 * fq;
                    f32x4 v0 = acc[ai][bj][m][0] * rs, v1 = acc[ai][bj][m][1] * rs;
                    if (kind == 1) {
                        const int hb = col0 & ~63, G4 = ((col0 & 63) >> 3) * 4;
                        const f32x4 cs = *(const f32x4*)(cosT + (size_t)row * 32 + G4), sn = *(const f32x4*)(sinT + (size_t)row * 32 + G4);
                        f32x4 o0 = v0 * cs - v1 * sn, o1 = v1 * cs + v0 * sn;
                        if (u.pn < 16) { o0 = o0 * QSCALE; o1 = o1 * QSCALE; }
                        u32x2 w0, w1; w0.x = cvt_pk_bf16(o0[0], o0[1]); w0.y = cvt_pk_bf16(o0[2], o0[3]); w1.x = cvt_pk_bf16(o1[0], o1[1]); w1.y = cvt_pk_bf16(o1[2], o1[3]);
                        *(u32x2*)(zr + hb + G4) = w0; *(u32x2*)(zr + hb + 32 + G4) = w1;
                    } else {
                        if (kind == 2) {
                            const f32x4 b0 = *(const f32x4*)(bgate + (col0 - C_GA)), b1 = *(const f32x4*)(bgate + (col0 - C_GA) + 4);
                            v0 = v0 + b0; v1 = v1 + b1;
#pragma unroll
                            for (int j = 0; j < 4; ++j) { v0[j] = sigmoidf_(v0[j]); v1[j] = sigmoidf_(v1[j]); }
                        }
                        u32x4 w; w.x = cvt_pk_bf16(v0[0], v0[1]); w.y = cvt_pk_bf16(v0[2], v0[3]); w.z = cvt_pk_bf16(v1[0], v1[1]); w.w = cvt_pk_bf16(v1[2], v1[3]);
                        *(u32x4*)(zr + col0) = w;
                    }
                }
            }
    }
};
struct Epi3 {
    static constexpr bool PERM = true, AFTER_DRAIN = false;
    const bf16_t* z; bf16_t* P; bf16_t* mb;
    __device__ __forceinline__ void operator()(const f32x4 (&acc)[2][2][4][2], const Unit& u, int wr, int wc, int fr, int fq) const {
        const bool second = u.pm >= 64; const int pm = u.pm & 63, pn = u.pn & 7;
#pragma unroll
        for (int ai = 0; ai < 2; ++ai)
#pragma unroll
            for (int m = 0; m < 4; ++m) {
                const int row = pm * 256 + ai * 128 + wr * 64 + m * 16 + fr;
#pragma unroll
                for (int bj = 0; bj < 2; ++bj) {
                    const int col0 = pn * 256 + bj * 128 + wc * 32 + 8 * fq;
                    float g[8]; unpack8(*(const u32x4*)(z + (size_t)row * DIN + (second ? C_GB : C_GA) + col0), g);
                    float v[8];
#pragma unroll
                    for (int j = 0; j < 4; ++j) { v[j] = acc[ai][bj][m][0][j] * g[j]; v[4 + j] = acc[ai][bj][m][1][j] * g[4 + j]; }
                    if (second) {
                        float p[8]; unpack8(*(const u32x4*)(P + (size_t)row * DM + col0), p);
#pragma unroll
                        for (int j = 0; j < 8; ++j) v[j] += p[j];
                        *(u32x4*)(mb + (size_t)row * DM + col0) = pack8(v);
                    } else {
                        *(u32x4*)(P + (size_t)row * DM + col0) = pack8(v);
                    }
                }
            }
    }
};
struct EpiRes {
    static constexpr bool PERM = true, AFTER_DRAIN = false;
    const float* hin; float* hout; bf16_t* hb; float* ssq;
    __device__ __forceinline__ void operator()(const f32x4 (&acc)[2][2][4][2], const Unit& u, int wr, int wc, int fr, int fq) const {
#pragma unroll
        for (int ai = 0; ai < 2; ++ai)
#pragma unroll
            for (int m = 0; m < 4; ++m) {
                const int row = u.pm * 256 + ai * 128 + wr * 64 + m * 16 + fr;
                float ss = 0.f;
#pragma unroll
                for (int bj = 0; bj < 2; ++bj) {
                    const int col0 = u.pn * 256 + bj * 128 + wc * 32 + 8 * fq;
                    const size_t off = (size_t)row * DM + col0;
                    const f32x4 h0 = *(const f32x4*)(hin + off) + acc[ai][bj][m][0], h1 = *(const f32x4*)(hin + off + 4) + acc[ai][bj][m][1];
                    *(f32x4*)(hout + off) = h0; *(f32x4*)(hout + off + 4) = h1;
                    ss += (h0[0] * h0[0] + h0[1] * h0[1]) + (h0[2] * h0[2] + h0[3] * h0[3]) + (h1[0] * h1[0] + h1[1] * h1[1]) + (h1[2] * h1[2] + h1[3] * h1[3]);
                    if (hb) { u32x4 w; w.x = cvt_pk_bf16(h0[0], h0[1]); w.y = cvt_pk_bf16(h0[2], h0[3]); w.z = cvt_pk_bf16(h1[0], h1[1]); w.w = cvt_pk_bf16(h1[2], h1[3]); *(u32x4*)(hb + off) = w; }
                }
                ss += __shfl_xor(ss, 16); ss += __shfl_xor(ss, 32);
                if (fq == 0) unsafeAtomicAdd(ssq + row, ss);
            }
    }
};
struct Epi5 {
    static constexpr bool PERM = true, AFTER_DRAIN = false;
    bf16_t* ups; const float* ssq2;
    __device__ __forceinline__ void operator()(const f32x4 (&acc)[2][2][4][2], const Unit& u, int wr, int wc, int fr, int fq) const {
#pragma unroll
        for (int ai = 0; ai < 2; ++ai)
#pragma unroll
            for (int m = 0; m < 4; ++m) {
                const int row = u.pm * 256 + ai * 128 + wr * 64 + m * 16 + fr;
                const float rs = 1.0f / sqrtf(ssq2[row] * (1.0f / DM) + EPS);
#pragma unroll
                for (int bj = 0; bj < 2; ++bj) {
                    const int col0 = u.pn * 256 + bj * 128 + wc * 32 + 8 * fq;
                    const f32x4 v0 = acc[ai][bj][m][0] * rs, v1 = acc[ai][bj][m][1] * rs;
                    u32x4 w; w.x = cvt_pk_bf16(v0[0], v0[1]); w.y = cvt_pk_bf16(v0[2], v0[3]); w.z = cvt_pk_bf16(v1[0], v1[1]); w.w = cvt_pk_bf16(v1[2], v1[3]);
                    *(u32x4*)(ups + (size_t)row * (2 * FFH) + col0) = w;
                }
            }
    }
};

enum { RM_ID = 0, RM_WIN = 1, RM_UP = 2 };
template <int RM> __device__ __forceinline__ int rowmap(int n) {
    if (RM == RM_WIN) { if (n >= C_Q && n < C_V) { const int base = n & ~63, d = n & 63; return base + 8 * ((d & 31) >> 2) + 4 * (d >> 5) + (d & 3); } return n; }
    if (RM == RM_UP) { const int isgv = n >= DFF ? 1 : 0; const int cc = n - DFF * isgv; const int half = cc >= FFH ? 1 : 0; const int j = cc - FFH * half; return 2 * FFH * half + FFH * isgv + j; }
    return n;
}
template <int RM> __device__ __forceinline__ void p0_transpose_item(const float* W, const float* gk, int K, int N, bf16_t* WT, int row_off, LAS float* scr, int item, int lane) {
    const int nblk = N / 32, kb = item / nblk, nb = item % nblk, k0 = 64 * kb, n0 = 32 * nb;
#pragma unroll 8
    for (int i = 0; i < 32; ++i) { const int kk = 2 * i + (lane >> 5); float w = W[(size_t)(k0 + kk) * N + n0 + (lane & 31)]; if (gk) w *= gk[k0 + kk]; scr[kk * 33 + (lane & 31)] = w; }
    asm volatile("s_waitcnt lgkmcnt(0)" ::: "memory");
    const int c = lane & 7;
#pragma unroll
    for (int j = 0; j < 4; ++j) { const int n = (lane >> 3) + 8 * j; const LAS float* s = scr + (8 * c) * 33 + n;
        u32x4 o; o.x = cvt_pk_bf16(s[0 * 33], s[1 * 33]); o.y = cvt_pk_bf16(s[2 * 33], s[3 * 33]); o.z = cvt_pk_bf16(s[4 * 33], s[5 * 33]); o.w = cvt_pk_bf16(s[6 * 33], s[7 * 33]);
        *(u32x4*)(WT + (size_t)(row_off + rowmap<RM>(n0 + n)) * K + k0 + 8 * c) = o; }
    asm volatile("s_waitcnt lgkmcnt(0)" ::: "memory");
}

struct Args { const float* in[15]; float* out; unsigned char* ws; int ph_lo, ph_hi; };

__device__ __forceinline__ void phase_prologue(const Args& a, LAS unsigned char* lds, int tid, int lane, int wave, int vcu, int G) {
    unsigned char* ws = a.ws;
    LAS float* scr = (LAS float*)(lds + wave * 16384);
    const int gw = vcu * NWAVES + wave, NGW = G * NWAVES;
    constexpr int I_IN = (DM / 64) * (DIN / 32), I_OA = (DCONV / 64) * (DM / 32), I_OB = (DATT / 64) * (DM / 32), I_MIX = (DM / 64) * (DM / 32), I_UP = (DM / 64) * (2 * DFF / 32), I_DN = (DFF / 64) * (DM / 32);
    constexpr int NITEMS = I_IN + I_OA + I_OB + I_MIX + I_UP + I_DN;
    for (int it = gw; it < NITEMS; it += NGW) {
        int r = it;
        if (r < I_IN) { p0_transpose_item<RM_WIN>(a.in[2], a.in[1], DM, DIN, (bf16_t*)(ws + WS_WIN), 0, scr, r, lane); continue; } r -= I_IN;
        if (r < I_OA) { p0_transpose_item<RM_ID>(a.in[5], nullptr, DCONV, DM, (bf16_t*)(ws + WS_BT3), 0, scr, r, lane); continue; } r -= I_OA;
        if (r < I_OB) { p0_transpose_item<RM_ID>(a.in[7], nullptr, DATT, DM, (bf16_t*)(ws + WS_BT3), DM, scr, r, lane); continue; } r -= I_OB;
        if (r < I_MIX) { p0_transpose_item<RM_ID>(a.in[8], nullptr, DM, DM, (bf16_t*)(ws + WS_WMIX), 0, scr, r, lane); continue; } r -= I_MIX;
        if (r < I_UP) { p0_transpose_item<RM_UP>(a.in[10], a.in[9], DM, 2 * DFF, (bf16_t*)(ws + WS_WUP), 0, scr, r, lane); continue; } r -= I_UP;
        p0_transpose_item<RM_ID>(a.in[13], nullptr, DFF, DM, (bf16_t*)(ws + WS_WDOWN), 0, scr, r, lane);
    }
    const float* x = a.in[0]; bf16_t* xb = (bf16_t*)(ws + WS_XB); float* rstd1 = (float*)(ws + WS_RSTD1);
    for (int m = gw; m < SEQ; m += NGW) {
        const f32x4* xr = (const f32x4*)(x + (size_t)m * DM) + lane; f32x4 v[8]; float s = 0.f;
#pragma unroll
        for (int j = 0; j < 8; ++j) { v[j] = xr[64 * j]; s += (v[j][0] * v[j][0] + v[j][1] * v[j][1]) + (v[j][2] * v[j][2] + v[j][3] * v[j][3]); }
        s = wave_sum(s);
        u32x2* o8 = (u32x2*)(xb + (size_t)m * DM) + lane;
#pragma unroll
        for (int j = 0; j < 8; ++j) { u32x2 w; w.x = cvt_pk_bf16(v[j][0], v[j][1]); w.y = cvt_pk_bf16(v[j][2], v[j][3]); o8[64 * j] = w; }
        if (lane == 0) rstd1[m] = 1.0f / sqrtf(s * (1.0f / DM) + EPS);
    }
    const int gt = vcu * NTHREADS + tid, NGT = G * NTHREADS;
    float* cosT = (float*)(ws + WS_COS); float* sinT = (float*)(ws + WS_SIN);
    for (int idx = gt; idx < SEQ * 32; idx += NGT) {
        const int t = idx >> 5, i = idx & 31;
        double f = 1.0; for (int k = 0; k < i; ++k) f *= 0.7498942093324559;
        const float inv = (float)f; const float angf = (float)t * inv;
        const double ang = (double)angf;
        const double kq = __builtin_rint(ang * 0.6366197723675814);
        double y = __builtin_fma(-kq, 1.5707963267948966, ang); y = __builtin_fma(-kq, 6.123233995736766e-17, y);
        const double y2 = y * y;
        double sp = -1.0 / 1307674368000.0; sp = sp * y2 + 1.0 / 6227020800.0; sp = sp * y2 - 1.0 / 39916800.0; sp = sp * y2 + 1.0 / 362880.0; sp = sp * y2 - 1.0 / 5040.0; sp = sp * y2 + 1.0 / 120.0; sp = sp * y2 - 1.0 / 6.0; sp = sp * y2 + 1.0; sp = sp * y;
        double cp = 1.0 / 20922789888000.0; cp = cp * y2 - 1.0 / 87178291200.0; cp = cp * y2 + 1.0 / 479001600.0; cp = cp * y2 - 1.0 / 3628800.0; cp = cp * y2 + 1.0 / 40320.0; cp = cp * y2 - 1.0 / 720.0; cp = cp * y2 + 1.0 / 24.0; cp = cp * y2 - 0.5; cp = cp * y2 + 1.0;
        const int q = ((int)kq) & 3;
        const double sv = (q == 0) ? sp : (q == 1) ? cp : (q == 2) ? -sp : -cp;
        const double cv = (q == 0) ? cp : (q == 1) ? -sp : (q == 2) ? -cp : sp;
        cosT[idx] = (float)cv; sinT[idx] = (float)sv;
    }
    float* ssq2 = (float*)(ws + WS_SSQ2); float* ssq3 = (float*)(ws + WS_SSQ3);
    for (int idx = gt; idx < SEQ; idx += NGT) { ssq2[idx] = 0.f; ssq3[idx] = 0.f; }
}

__device__ __forceinline__ void load_cv(const bf16_t* z, int t, int c0, float (&cv)[8]) {
    if (t < 0 || t >= SEQ) {
#pragma unroll
        for (int j = 0; j < 8; ++j) cv[j] = 0.f;
        return;
    }
    float c[8], v[8]; unpack8(*(const u32x4*)(z + (size_t)t * DIN + C_CA + c0), c); unpack8(*(const u32x4*)(z + (size_t)t * DIN + C_VA + c0), v);
#pragma unroll
    for (int j = 0; j < 8; ++j) cv[j] = c[j] * v[j];
}
__device__ __forceinline__ void phase_mixer(const Args& a, int lane, int gw, int NGW) {
    const bf16_t* z = (const bf16_t*)(a.ws + WS_Z); bf16_t* ya = (bf16_t*)a.out; const float* cw = a.in[4];
    for (int it = gw; it < (SEQ / 16) * 2; it += NGW) {
        const int t0 = (it >> 1) * 16, c0 = (it & 1) * 512 + 8 * lane;
        float w0[8], w1[8], w2[8];
#pragma unroll
        for (int j = 0; j < 8; ++j) { w0[j] = cw[c0 + j]; w1[j] = cw[DCONV + c0 + j]; w2[j] = cw[2 * DCONV + c0 + j]; }
        float prev[8], cur[8], nxt[8];
        load_cv(z, t0 - 1, c0, prev); load_cv(z, t0, c0, cur);
        for (int t = t0; t < t0 + 16; ++t) {
            load_cv(z, t + 1, c0, nxt);
            float b[8]; unpack8(*(const u32x4*)(z + (size_t)t * DIN + C_BA + c0), b);
            float o[8];
#pragma unroll
            for (int j = 0; j < 8; ++j) { o[j] = b[j] * (w0[j] * prev[j] + w1[j] * cur[j] + w2[j] * nxt[j]); prev[j] = cur[j]; cur[j] = nxt[j]; }
            *(u32x4*)(ya + (size_t)t * DCONV + c0) = pack8(o);
        }
    }
}

constexpr int KROW = 144, VROW = 656, KWIN = 320, LDS_KB = KWIN * KROW;
__device__ __forceinline__ void attn_unit(LAS unsigned char* lds, const bf16_t* z, const bf16_t* vT, bf16_t* att, const float* sink, int kh, int qb, int tid) {
    asm volatile("" : "+v"(tid));
    const int lane = tid & 63, wid = __builtin_amdgcn_readfirstlane(tid >> 6), l31 = lane & 31, hi = lane >> 5;
    const int q0 = qb * 64;
#pragma unroll
    for (int i = 0; i < 5; ++i) {
        const int id = tid + 512 * i, r = id >> 3, ch = id & 7, t = q0 - 128 + r;
        u32x4 v = (u32x4){0u, 0u, 0u, 0u};
        if (t >= 0 && t < SEQ) v = *(const u32x4*)(z + (size_t)t * DIN + C_K + 64 * kh + 8 * ch);
        *(LAS u32x4*)(lds + r * KROW + ch * 16) = v;
    }
#pragma unroll
    for (int i = 0; i < 5; ++i) {
        const int id = tid + 512 * i, d = id / 40, ch = id - d * 40, t = q0 - 128 + 8 * ch;
        u32x4 v = (u32x4){0u, 0u, 0u, 0u};
        if (t >= 0 && t < SEQ) v = *(const u32x4*)(vT + (size_t)(64 * kh + d) * SEQ + t);
        *(LAS u32x4*)(lds + LDS_KB + d * VROW + ch * 16) = v;
    }
    __syncthreads();
    const int g = wid >> 1, sb = wid & 1, head = 4 * kh + g, q0w = q0 + 32 * sb;
    bf16x8 qr[4];
#pragma unroll
    for (int ds = 0; ds < 4; ++ds) qr[ds] = *(const bf16x8*)(z + (size_t)(q0w + l31) * DIN + C_Q + head * 64 + 16 * ds + 8 * hi);
    const int pi = (l31 & 0x13) | ((l31 & 4) << 1) | ((l31 & 8) >> 1);
    f32x16 s[9];
#pragma unroll
    for (int tl = 0; tl < 9; ++tl) {
        const LAS unsigned char* kp = lds + (32 * (sb + tl) + pi) * KROW + 16 * hi;
        f32x16 acc = (f32x16){0.f, 0.f, 0.f, 0.f, 0.f, 0.f, 0.f, 0.f, 0.f, 0.f, 0.f, 0.f, 0.f, 0.f, 0.f, 0.f};
#pragma unroll
        for (int ds = 0; ds < 4; ++ds) { const bf16x8 kf = *(const LAS bf16x8*)(kp + 32 * ds); acc = __builtin_amdgcn_mfma_f32_32x32x16_bf16(kf, qr[ds], acc, 0, 0, 0); }
        s[tl] = acc;
    }
    const float sinkl = sink[head] * LOG2E;
    float mx = sinkl;
    const int qpos = q0w + l31;
#pragma unroll
    for (int tl = 0; tl < 9; ++tl)
#pragma unroll
        for (int r = 0; r < 16; ++r) {
            const int kpos = q0w - 128 + 32 * tl + 16 * (r >> 3) + 8 * hi + (r & 7);
            const int dlt = kpos - qpos;
            const bool ok = (dlt >= -128) && (dlt <= 128) && (kpos >= 0) && (kpos < SEQ);
            const float v = ok ? s[tl][r] : -INFINITY;
            s[tl][r] = v; mx = fmaxf(mx, v);
        }
    mx = fmaxf(mx, __shfl_xor(mx, 32));
    float sum = 0.f;
#pragma unroll
    for (int tl = 0; tl < 9; ++tl)
#pragma unroll
        for (int r = 0; r < 16; ++r) { const float p = __builtin_amdgcn_exp2f(s[tl][r] - mx); s[tl][r] = p; sum += p; }
    sum += __shfl_xor(sum, 32);
    const float inv = 1.0f / (sum + __builtin_amdgcn_exp2f(sinkl - mx));
    f32x16 o[2];
    o[0] = (f32x16){0.f, 0.f, 0.f, 0.f, 0.f, 0.f, 0.f, 0.f, 0.f, 0.f, 0.f, 0.f, 0.f, 0.f, 0.f, 0.f}; o[1] = o[0];
#pragma unroll
    for (int tl = 0; tl < 9; ++tl)
#pragma unroll
        for (int s2 = 0; s2 < 2; ++s2) {
            u32x4 pw; pw.x = cvt_pk_bf16(s[tl][8 * s2 + 0], s[tl][8 * s2 + 1]); pw.y = cvt_pk_bf16(s[tl][8 * s2 + 2], s[tl][8 * s2 + 3]);
            pw.z = cvt_pk_bf16(s[tl][8 * s2 + 4], s[tl][8 * s2 + 5]); pw.w = cvt_pk_bf16(s[tl][8 * s2 + 6], s[tl][8 * s2 + 7]);
            const bf16x8 pb = __builtin_bit_cast(bf16x8, pw);
#pragma unroll
            for (int db = 0; db < 2; ++db) {
                const bf16x8 vf = *(const LAS bf16x8*)(lds + LDS_KB + (32 * db + l31) * VROW + (32 * (sb + tl) + 16 * s2 + 8 * hi) * 2);
                o[db] = __builtin_amdgcn_mfma_f32_32x32x16_bf16(vf, pb, o[db], 0, 0, 0);
            }
        }
    bf16_t* orow = att + (size_t)(q0w + l31) * DATT + head * 64;
#pragma unroll
    for (int db = 0; db < 2; ++db)
#pragma unroll
        for (int rg = 0; rg < 4; ++rg) {
            u32x2 w; w.x = cvt_pk_bf16(o[db][4 * rg + 0] * inv, o[db][4 * rg + 1] * inv); w.y = cvt_pk_bf16(o[db][4 * rg + 2] * inv, o[db][4 * rg + 3] * inv);
            *(u32x2*)(orow + 32 * db + 8 * rg + 4 * hi) = w;
        }
    __syncthreads();
}

__device__ __forceinline__ void load_up(const bf16_t* ups, int t, int j0, float (&ua)[8], float (&ug)[8]) {
    if (t < 0 || t >= SEQ) {
#pragma unroll
        for (int j = 0; j < 8; ++j) { ua[j] = 0.f; ug[j] = 0.f; }
        return;
    }
    unpack8(*(const u32x4*)(ups + (size_t)t * (2 * FFH) + j0), ua); unpack8(*(const u32x4*)(ups + (size_t)t * (2 * FFH) + FFH + j0), ug);
}
__device__ __forceinline__ void phase_ffnconv(const Args& a, int half, int lane, int gw, int NGW) {
    const bf16_t* ups = (const bf16_t*)(a.ws + WS_UPS); bf16_t* act = (bf16_t*)(a.ws + WS_ACT); const float* cw = a.in[11]; const float* cb = a.in[12];
    for (int it = gw; it < (SEQ / 16) * 6; it += NGW) {
        const int run = it / 6, cg6 = it - run * 6, chunk = 64 * cg6 + lane, t0 = run * 16;
        if (chunk >= FFH / 8) continue;
        const int j0 = 8 * chunk, ca = FFH * half + j0;
        float wa0[8], wa1[8], wa2[8], ba[8], wg0[8], wg1[8], wg2[8], bg[8];
#pragma unroll
        for (int j = 0; j < 8; ++j) {
            wa0[j] = cw[ca + j]; wa1[j] = cw[2 * DFF + ca + j]; wa2[j] = cw[4 * DFF + ca + j]; ba[j] = cb[ca + j];
            wg0[j] = cw[DFF + ca + j]; wg1[j] = cw[3 * DFF + ca + j]; wg2[j] = cw[5 * DFF + ca + j]; bg[j] = cb[DFF + ca + j];
        }
        float pa_[8], pg_[8], ca_[8], cg_[8], na_[8], ng_[8];
        load_up(ups, t0 - 1, j0, pa_, pg_); load_up(ups, t0, j0, ca_, cg_);
        for (int t = t0; t < t0 + 16; ++t) {
            load_up(ups, t + 1, j0, na_, ng_);
            float o[8];
#pragma unroll
            for (int j = 0; j < 8; ++j) {
                const float A = wa0[j] * pa_[j] + wa1[j] * ca_[j] + wa2[j] * na_[j] + ba[j];
                const float Gv = wg0[j] * pg_[j] + wg1[j] * cg_[j] + wg2[j] * ng_[j] + bg[j];
                o[j] = A * sigmoidf_(A) * Gv;
                pa_[j] = ca_[j]; ca_[j] = na_[j]; pg_[j] = cg_[j]; cg_[j] = ng_[j];
            }
            *(u32x4*)(act + (size_t)t * DFF + ca) = pack8(o);
        }
    }
}

constexpr size_t WS_BAR = 196608 + 256;
__device__ __forceinline__ void grid_barrier(unsigned* cnt, unsigned target) {
    asm volatile("s_waitcnt vmcnt(0)" ::: "memory");
    __syncthreads();
    if (threadIdx.x == 0) {
        __builtin_amdgcn_fence(__ATOMIC_RELEASE, "agent");
        asm volatile("s_waitcnt vmcnt(0)" ::: "memory");
        __hip_atomic_fetch_add(cnt, 1u, __ATOMIC_RELAXED, __HIP_MEMORY_SCOPE_AGENT);
        while (__hip_atomic_load(cnt, __ATOMIC_RELAXED, __HIP_MEMORY_SCOPE_AGENT) < target) __builtin_amdgcn_s_sleep(2);
        __builtin_amdgcn_fence(__ATOMIC_ACQUIRE, "agent");
        asm volatile("s_waitcnt vmcnt(0)" ::: "memory");
    }
    __syncthreads();
}

__global__ void __launch_bounds__(NTHREADS, 2) fwd_megakernel(Args args) {
    extern __shared__ __attribute__((aligned(16))) unsigned char lds_raw[];
    LAS unsigned char* lds = (LAS unsigned char*)lds_raw;
    const int tid = threadIdx.x, lane = tid & 63, wave = __builtin_amdgcn_readfirstlane(tid >> 6);
    const int G = gridDim.x, bx = blockIdx.x;
    const int vcu = (G % 8 == 0) ? (bx % 8) * (G / 8) + bx / 8 : bx;
    const int gw = vcu * NWAVES + wave, NGW = G * NWAVES;
    unsigned char* ws = args.ws;
    const int lo = args.ph_lo, hi = args.ph_hi;
#define IN(k) (lo <= (k) && (k) < hi)
    unsigned* barw = (unsigned*)(ws + WS_BAR); unsigned nbar = 0;
#define SEAM(k) do { if (IN(k) && IN((k) + 1)) { nbar += (unsigned)G; grid_barrier(barw, nbar); } } while (0)

    if (IN(0)) {
        if (bx == 0 && tid == 0) __hip_atomic_store(barw, 0u, __ATOMIC_RELAXED, __HIP_MEMORY_SCOPE_AGENT);
        phase_prologue(args, lds, tid, lane, wave, vcu, G);
    }
    if (IN(0) && IN(1)) { cg::this_grid().sync(); }
    if (IN(1)) {
        Gemm g{(const bf16_t*)(ws + WS_XB), (const bf16_t*)(ws + WS_WIN), SEQ, DIN, DM}; Sched1 S; S.init(G, bx);
        Epi1 E{(bf16_t*)(ws + WS_Z), (bf16_t*)(ws + WS_VT), (const float*)(ws + WS_RSTD1), (const float*)(ws + WS_COS), (const float*)(ws + WS_SIN), args.in[3]};
        pg8::gemm_phase<Epi1, Sched1, true, true>(lds, g, S, E);
    }
    SEAM(1);
    if (IN(2)) {
        phase_mixer(args, lane, gw, NGW);
        const bf16_t* z = (const bf16_t*)(ws + WS_Z); const bf16_t* vT = (const bf16_t*)(ws + WS_VT); bf16_t* att = (bf16_t*)args.out + (size_t)SEQ * DCONV;
        for (int u = vcu; u < NKV * (SEQ / 64); u += G) attn_unit(lds, z, vT, att, args.in[6], u & 3, u >> 2, tid);
    }
    SEAM(2);
    if (IN(3)) {
        Gemm g{(const bf16_t*)args.out, (const bf16_t*)(ws + WS_BT3), 2 * SEQ, 2 * DM, DCONV}; Sched3 S; S.init(G, bx);
        Epi3 E{(const bf16_t*)(ws + WS_Z), (bf16_t*)args.out + (size_t)2 * SEQ * DCONV, (bf16_t*)(ws + WS_MB)};
        pg8::gemm_phase<Epi3, Sched3, true, true>(lds, g, S, E);
    }
    SEAM(3);
    if (IN(4)) {
        Gemm g{(const bf16_t*)(ws + WS_MB), (const bf16_t*)(ws + WS_WMIX), SEQ, DM, DM}; pg8::StaticOrder S; S.init(SEQ, DM, G, bx);
        EpiRes E{args.in[0], args.out, (bf16_t*)(ws + WS_H1B), (float*)(ws + WS_SSQ2)};
        pg8::gemm_phase<EpiRes, pg8::StaticOrder, true, true>(lds, g, S, E);
    }
    SEAM(4);
#pragma unroll 1
    for (int half = 0; half < 2; ++half) {
        if (IN(5 + 2 * half)) {
            Gemm g{(const bf16_t*)(ws + WS_H1B), (const bf16_t*)(ws + WS_WUP) + (size_t)half * (2 * FFH) * DM, SEQ, 2 * FFH, DM}; pg8::StaticOrder S; S.init(SEQ, 2 * FFH, G, bx);
            Epi5 E{(bf16_t*)(ws + WS_UPS), (const float*)(ws + WS_SSQ2)};
            pg8::gemm_phase<Epi5, pg8::StaticOrder, true, true>(lds, g, S, E);
        }
        SEAM(5 + 2 * half);
        if (IN(6 + 2 * half)) { phase_ffnconv(args, half, lane, gw, NGW); }
        SEAM(6 + 2 * half);
    }
    if (IN(9)) {
        Gemm g{(const bf16_t*)(ws + WS_ACT), (const bf16_t*)(ws + WS_WDOWN), SEQ, DM, DFF}; pg8::StaticOrder S; S.init(SEQ, DM, G, bx);
        EpiRes E{args.out, args.out, nullptr, (float*)(ws + WS_SSQ3)};
        pg8::gemm_phase<EpiRes, pg8::StaticOrder, true, true>(lds, g, S, E);
    }
    SEAM(9);
    if (IN(10)) {
        const float* ssq3 = (const float*)(ws + WS_SSQ3); const float* gf = args.in[14];
        for (int m = gw; m < SEQ; m += NGW) {
            const float rs = 1.0f / sqrtf(ssq3[m] * (1.0f / DM) + EPS);
            f32x4* xr = (f32x4*)(args.out + (size_t)m * DM) + lane; const f32x4* gr = (const f32x4*)gf + lane;
#pragma unroll
            for (int j = 0; j < 8; ++j) { const f32x4 v = xr[64 * j] * rs * gr[64 * j]; xr[64 * j] = v; }
        }
    }
#undef IN
#undef SEAM
}

constexpr int N_PHASES = 11;
extern "C" void kernel_launch(void* const* d_in, const int* in_sizes, int n_in, void* d_out, int out_size, void* d_ws, size_t ws_size, hipStream_t stream) {
    static int grid = 0;
    if (grid == 0) {
        if (n_in != 15 || in_sizes[0] != SEQ * DM || out_size != SEQ * DM || ws_size < WS_END) { fprintf(stderr, "kernel_launch: unexpected shapes / workspace (n_in %d, in0 %d, out %d, ws %zu)\n", n_in, n_in > 0 ? in_sizes[0] : -1, out_size, ws_size); grid = -1; return; }
        int dev = 0, cus = 0;
        if (hipGetDevice(&dev) != hipSuccess || hipDeviceGetAttribute(&cus, hipDeviceAttributeMultiprocessorCount, dev) != hipSuccess) { grid = -1; return; }
        if (hipFuncSetAttribute((const void*)fwd_megakernel, hipFuncAttributeMaxDynamicSharedMemorySize, LDS_BYTES) != hipSuccess) { fprintf(stderr, "kernel_launch: hipFuncSetAttribute failed\n"); grid = -1; return; }
        int per_cu = 0;
        if (hipOccupancyMaxActiveBlocksPerMultiprocessor(&per_cu, (const void*)fwd_megakernel, NTHREADS, LDS_BYTES) != hipSuccess || per_cu < 1) { fprintf(stderr, "kernel_launch: occupancy query says %d blocks per CU\n", per_cu); (void)hipGetLastError(); }
        grid = cus;
    }
    if (grid < 0) return;
    Args a{};
    for (int i = 0; i < 15; ++i) a.in[i] = (const float*)d_in[i];
    a.out = (float*)d_out; a.ws = (unsigned char*)d_ws;
#if MK_N_LAUNCHES == 1
    a.ph_lo = 0; a.ph_hi = N_PHASES;
    void* kargs[] = {&a};
    hipError_t e = hipLaunchCooperativeKernel((const void*)fwd_megakernel, dim3(grid), dim3(NTHREADS), kargs, LDS_BYTES, stream);
    if (e != hipSuccess) fprintf(stderr, "kernel_launch: cooperative launch failed: %s (grid %d)\n", hipGetErrorString(e), grid);
#else
    for (int ph = 0; ph < N_PHASES; ++ph) {
        a.ph_lo = ph; a.ph_hi = ph + 1;
        hipLaunchKernelGGL(fwd_megakernel, dim3(grid), dim3(NTHREADS), LDS_BYTES, stream, a);
    }
#endif
}
```

```cpp
#include <hip/hip_runtime.h>
#include <hip/hip_cooperative_groups.h>
#include <cstdio>
#include <cstdint>
namespace cg = cooperative_groups;
#ifndef MK_N_LAUNCHES
#define MK_N_LAUNCHES 1
#endif

namespace pg8 {
#define PG8_LAS __attribute__((address_space(3)))
typedef unsigned short bf16_t;
typedef short bf16x8 __attribute__((ext_vector_type(8)));
typedef float f32x4 __attribute__((ext_vector_type(4)));
typedef unsigned u32x4 __attribute__((ext_vector_type(4)));
constexpr int BM = 256, BK = 64, HALF = 128, HTB = HALF * BK * 2  , STAGE_BYTES = 8 * HTB, NXCD = 8, WGM = 8;

__host__ __device__ __forceinline__ int lds_byte(int r, int c) { const int st = (r >> 4) * 2 + (c >> 5), rr = r & 15, cc = c & 31, ob = rr * 64 + cc * 2; return st * 1024 + (ob ^ (((ob >> 9) & 1) << 5)); }
__host__ __device__ __forceinline__ void stage_rc(int b, int& R, int& C) { const int st = b / 1024, sb = b % 1024, swz = sb ^ (((sb >> 9) & 1) << 5); R = (st >> 1) * 16 + swz / 64; C = (st & 1) * 32 + (swz % 64) / 2; }
__host__ __device__ __forceinline__ int perm32(int rho) { const int n = rho >> 4, i = rho & 15; return 8 * (i >> 2) + 4 * n + (i & 3); }

struct Unit { int pm, pn; };
struct Gemm { const bf16_t* A; const bf16_t* Bt; int M, N, K; };

struct StaticOrder {
    int nM, nN, nwg, G, c;
    __host__ __device__ void init(int M, int N, int G_, int c_) { nM = M / BM; nN = N / BM; nwg = nM * nN; G = G_; c = c_; }
    __host__ __device__ bool next(int i, Unit& u) const {
        const long L = (long)i * G + c; if (L >= nwg) return false;
        int wgid = (int)L; { const int q = nwg / NXCD, r = nwg % NXCD, xcd = wgid % NXCD, off = wgid / NXCD; wgid = (xcd < r ? xcd * (q + 1) : r * (q + 1) + (xcd - r) * q) + off; }
        const int nig = WGM * nN, gid = wgid / nig, fm = gid * WGM, gsz = (nM - fm) < WGM ? (nM - fm) : WGM;
        u.pm = fm + ((wgid % nig) % gsz); u.pn = (wgid % nig) / gsz; return true;
    }
    __device__ __forceinline__ const char* pa(const Gemm& g, const Unit& u, size_t tstep) const { return (const char*)g.A + (size_t)u.pm * tstep; }
    __device__ __forceinline__ const char* pb(const Gemm& g, const Unit& u, size_t tstep) const { return (const char*)g.Bt + (size_t)u.pn * tstep; }
    __device__ __forceinline__ void a_ready(const Unit&) const {}
    __device__ __forceinline__ void done(const Unit&) const {}
};

__device__ __forceinline__ unsigned cvt_pk_bf16(float lo, float hi) { unsigned r; asm volatile("v_cvt_pk_bf16_f32 %0, %1, %2" : "=v"(r) : "v"(lo), "v"(hi)); return r; }
typedef float f32x2 __attribute__((ext_vector_type(2)));
template <class Epi, class Sched, bool ALIGN_EPI = false, bool SP2 = false>
__device__ __forceinline__ void gemm_phase(PG8_LAS unsigned char* lds, const Gemm g, const Sched& S, const Epi& E) {
    const int tid = threadIdx.x, wid = __builtin_amdgcn_readfirstlane(tid >> 6), lane = tid & 63, wr = wid >> 2, wc = wid & 3, fr = lane & 15, fq = lane >> 4;
    const int K = g.K, nt = K / BK;
    unsigned voffA[2], voffB[2];
#pragma unroll
    for (int i = 0; i < 2; ++i) { int R, C; stage_rc(tid * 16 + i * 8192, R, C); const int Rb = Epi::PERM ? ((R & ~31) + perm32(R & 31)) : R;
        voffA[i] = (unsigned)(R * K + C) * 2u; voffB[i] = (unsigned)(Rb * K + C) * 2u; }
    const size_t kstep = (size_t)(BK * 2);
    const size_t hstep = (size_t)HALF * K * 2;
    const size_t tstep = 2 * hstep;
    const unsigned ldsw = (unsigned)wid * 1024u;
    const int aoff = lds_byte(wr * 64 + fr, fq * 8), boff = lds_byte(wc * 32 + fr, fq * 8);
#define PG8_SA(b, h) (((b) * 2 + (h)) * HTB)
#define PG8_SB(b, h) ((4 + (b) * 2 + (h)) * HTB)
#define PG8_STAGE(bufoff, gbase, voff) do { _Pragma("unroll") for (int _i = 0; _i < 2; ++_i) \
        __builtin_amdgcn_global_load_lds((const unsigned*)((const char*)(gbase) + (voff)[_i]), (PG8_LAS unsigned*)(lds + (bufoff) + ldsw + _i * 8192), 16, 0, 0); } while (0)
#define PG8_LDA(dst, b, h) do { _Pragma("unroll") for (int m = 0; m < 4; ++m) _Pragma("unroll") for (int k = 0; k < 2; ++k) dst[m][k] = *(const PG8_LAS bf16x8*)(lds + PG8_SA(b, h) + aoff + m * 2048 + k * 1024); } while (0)
#define PG8_LDB(dst, b, h) do { _Pragma("unroll") for (int n = 0; n < 2; ++n) _Pragma("unroll") for (int k = 0; k < 2; ++k) dst[n][k] = *(const PG8_LAS bf16x8*)(lds + PG8_SB(b, h) + boff + n * 2048 + k * 1024); } while (0)
#define PG8_MMA(ai, bj, At, Bt) do { __builtin_amdgcn_s_setprio(1); _Pragma("unroll") for (int m = 0; m < 4; ++m) _Pragma("unroll") for (int n = 0; n < 2; ++n) _Pragma("unroll") for (int k = 0; k < 2; ++k) \
        acc[ai][bj][m][n] = __builtin_amdgcn_mfma_f32_16x16x32_bf16(Bt[n][k], At[m][k], acc[ai][bj][m][n], 0, 0, 0); __builtin_amdgcn_s_setprio(0); } while (0)
#define PG8_WAIT_V(n) asm volatile("s_waitcnt vmcnt(" #n ")" ::: "memory")
#define PG8_WAIT_L(n) asm volatile("s_waitcnt lgkmcnt(" #n ")" ::: "memory")
#define PG8_BAR __builtin_amdgcn_s_barrier()
#define PG8_SCHED __builtin_amdgcn_sched_barrier(0)
    Unit cur, nxt; int ui = 0;
    if (!S.next(0, cur)) return;
    f32x4 acc[2][2][4][2];
#pragma unroll
    for (int a = 0; a < 2; ++a)
#pragma unroll
        for (int b = 0; b < 2; ++b)
#pragma unroll
            for (int m = 0; m < 4; ++m)
#pragma unroll
                for (int n = 0; n < 2; ++n) acc[a][b][m][n] = (f32x4){0.f, 0.f, 0.f, 0.f};
    bf16x8 At[4][2], B0[2][2], B1[2][2];
    const char* cA = S.pa(g, cur, tstep); const char* cB = S.pb(g, cur, tstep);
    S.a_ready(cur);
    if constexpr (SP2) {
        PG8_STAGE(PG8_SB(0, 0), cB, voffB); PG8_STAGE(PG8_SB(0, 1), cB + hstep, voffB); PG8_STAGE(PG8_SA(0, 0), cA, voffA); PG8_STAGE(PG8_SA(0, 1), cA + hstep, voffA);
        if (wr == 1) PG8_BAR;
        PG8_WAIT_V(2); PG8_BAR;
        PG8_STAGE(PG8_SB(1, 0), cB + kstep, voffB); PG8_STAGE(PG8_SA(1, 0), cA + kstep, voffA); PG8_STAGE(PG8_SB(1, 1), cB + hstep + kstep, voffB);
        PG8_WAIT_V(6); PG8_BAR;
    } else {
        PG8_STAGE(PG8_SB(0, 0), cB, voffB); PG8_STAGE(PG8_SA(0, 0), cA, voffA); PG8_STAGE(PG8_SB(0, 1), cB + hstep, voffB); PG8_STAGE(PG8_SA(0, 1), cA + hstep, voffA);
        if (wr == 1) PG8_BAR;
        PG8_WAIT_V(4); PG8_BAR;
        PG8_STAGE(PG8_SB(1, 0), cB + kstep, voffB); PG8_STAGE(PG8_SA(1, 0), cA + kstep, voffA); PG8_STAGE(PG8_SB(1, 1), cB + hstep + kstep, voffB);
        PG8_WAIT_V(6); PG8_BAR;
    }
    for (;;) {
        const bool has_next = S.next(ui + 1, nxt);
        const char* nA = has_next ? S.pa(g, nxt, tstep) : cA; const char* nB = has_next ? S.pb(g, nxt, tstep) : cB;
        for (int t = 0; t < nt; t += 2) {
            const bool last = (t == nt - 2);
            const char* a1 = cA + (size_t)(t + 1) * kstep;
            const char* a2 = last ? nA : cA + (size_t)(t + 2) * kstep; const char* b2 = last ? nB : cB + (size_t)(t + 2) * kstep;
            const char* a3 = a2 + kstep; const char* b3 = b2 + kstep;
            if (last && has_next) S.a_ready(nxt);
            if constexpr (SP2) {
            PG8_LDB(B0, 0, 0); PG8_LDB(B1, 0, 1); PG8_SCHED; PG8_LDA(At, 0, 0); PG8_STAGE(PG8_SA(1, 1), a1 + hstep, voffA);
            PG8_WAIT_V(8); PG8_WAIT_L(0); PG8_BAR; PG8_MMA(0, 0, At, B0); PG8_MMA(0, 1, At, B1); PG8_BAR; PG8_SCHED;
            PG8_LDA(At, 0, 1); PG8_STAGE(PG8_SB(0, 0), b2, voffB); PG8_STAGE(PG8_SB(0, 1), b2 + hstep, voffB); PG8_STAGE(PG8_SA(0, 0), a2, voffA);
            PG8_WAIT_V(8); PG8_WAIT_L(0); PG8_BAR; PG8_MMA(1, 0, At, B0); PG8_MMA(1, 1, At, B1); PG8_BAR; PG8_SCHED;
            PG8_LDB(B0, 1, 0); PG8_LDB(B1, 1, 1); PG8_SCHED; PG8_LDA(At, 1, 0); PG8_STAGE(PG8_SA(0, 1), a2 + hstep, voffA);
            PG8_WAIT_V(8); PG8_WAIT_L(0); PG8_BAR; PG8_MMA(0, 0, At, B0); PG8_MMA(0, 1, At, B1); PG8_BAR; PG8_SCHED;
            PG8_LDA(At, 1, 1); PG8_STAGE(PG8_SB(1, 0), b3, voffB); PG8_STAGE(PG8_SB(1, 1), b3 + hstep, voffB); PG8_STAGE(PG8_SA(1, 0), a3, voffA);
            PG8_WAIT_V(8); PG8_WAIT_L(0); PG8_BAR; PG8_MMA(1, 0, At, B0); PG8_MMA(1, 1, At, B1); PG8_BAR; PG8_SCHED;
            } else {
            PG8_LDB(B0, 0, 0); PG8_SCHED; PG8_LDA(At, 0, 0); PG8_STAGE(PG8_SA(1, 1), a1 + hstep, voffA);
            PG8_WAIT_L(8); PG8_BAR; PG8_WAIT_L(0); PG8_MMA(0, 0, At, B0); PG8_BAR; PG8_SCHED;
            PG8_LDB(B1, 0, 1); PG8_STAGE(PG8_SB(0, 0), b2, voffB);
            PG8_BAR; PG8_WAIT_L(0); PG8_MMA(0, 1, At, B1); PG8_BAR;
            PG8_LDA(At, 0, 1); PG8_STAGE(PG8_SA(0, 0), a2, voffA);
            PG8_BAR; PG8_WAIT_L(0); PG8_MMA(1, 0, At, B0); PG8_BAR; PG8_SCHED;
            PG8_STAGE(PG8_SB(0, 1), b2 + hstep, voffB);
            PG8_WAIT_V(6); PG8_BAR; PG8_MMA(1, 1, At, B1); PG8_BAR;
            PG8_LDB(B0, 1, 0); PG8_SCHED; PG8_LDA(At, 1, 0); PG8_STAGE(PG8_SA(0, 1), a2 + hstep, voffA);
            PG8_WAIT_L(8); PG8_BAR; PG8_WAIT_L(0); PG8_MMA(0, 0, At, B0); PG8_BAR; PG8_SCHED;
            PG8_LDB(B1, 1, 1); PG8_STAGE(PG8_SB(1, 0), b3, voffB);
            PG8_BAR; PG8_WAIT_L(0); PG8_MMA(0, 1, At, B1); PG8_BAR;
            PG8_LDA(At, 1, 1); PG8_STAGE(PG8_SA(1, 0), a3, voffA);
            PG8_BAR; PG8_WAIT_L(0); PG8_MMA(1, 0, At, B0); PG8_BAR; PG8_SCHED;
            PG8_STAGE(PG8_SB(1, 1), b3 + hstep, voffB);
            PG8_WAIT_V(6); PG8_BAR; PG8_MMA(1, 1, At, B1); PG8_BAR;
            }
        }
        if constexpr (ALIGN_EPI) { if (wr == 0) PG8_BAR; }
        if constexpr (!Epi::AFTER_DRAIN) { E(acc, cur, wr, wc, fr, fq); S.done(cur); }
        if (!has_next) break;
#pragma unroll
        for (int a = 0; a < 2; ++a)
#pragma unroll
            for (int b = 0; b < 2; ++b)
#pragma unroll
                for (int m = 0; m < 4; ++m)
#pragma unroll
                    for (int n = 0; n < 2; ++n) acc[a][b][m][n] = (f32x4){0.f, 0.f, 0.f, 0.f};
        cur = nxt; cA = nA; cB = nB; ++ui;
        if constexpr (ALIGN_EPI) { if (wr == 1) PG8_BAR; }
    }
    PG8_WAIT_V(0);
    if constexpr (!ALIGN_EPI) { if (wr == 0) PG8_BAR; }
    PG8_BAR;
    if constexpr (Epi::AFTER_DRAIN) { E.fused(acc, cur, wr, wc, fr, fq, lds, wid, lane); S.done(cur); }
#undef PG8_SA
#undef PG8_SB
#undef PG8_STAGE
#undef PG8_LDA
#undef PG8_LDB
#undef PG8_MMA
#undef PG8_WAIT_V
#undef PG8_WAIT_L
#undef PG8_BAR
#undef PG8_SCHED
}
}

using pg8::bf16_t; using pg8::bf16x8; using pg8::f32x4; using pg8::u32x4; using pg8::cvt_pk_bf16; using pg8::Unit; using pg8::Gemm;
#define LAS __attribute__((address_space(3)))
typedef float f32x16 __attribute__((ext_vector_type(16)));
typedef unsigned u32x2 __attribute__((ext_vector_type(2)));
constexpr int SEQ = 16384, DM = 2048, DCONV = 1024, NH = 16, NKV = 4, HD = 64, DATT = 1024, DFF = 5632, FFH = 2816;
constexpr int DIN = 8704;
constexpr int C_BA = 0, C_CA = 1024, C_VA = 2048, C_Q = 3072, C_K = 4096, C_V = 4352, C_GA = 4608, C_GB = 6656;
constexpr float EPS = 1e-6f;
constexpr float LOG2E = 1.4426950408889634f;
constexpr float QSCALE = 0.125f * 1.4426950408889634f;
constexpr int NWAVES = 8, NTHREADS = 512;
constexpr int LDS_BYTES = 147456;

constexpr size_t MiB = (size_t)1 << 20;
constexpr size_t WS_SSQ2 = 0, WS_SSQ3 = 65536, WS_RSTD1 = 131072;
constexpr size_t WS_COS = 1 * MiB, WS_SIN = 3 * MiB;
constexpr size_t WS_WUP = 6 * MiB, WS_WDOWN = 50 * MiB;
constexpr size_t WS_Z = 72 * MiB;
constexpr size_t WS_H1B = 72 * MiB;
constexpr size_t WS_VT = 344 * MiB;
constexpr size_t WS_XB = 352 * MiB, WS_MB = 352 * MiB;
constexpr size_t WS_WIN = 416 * MiB, WS_BT3 = 450 * MiB, WS_WMIX = 458 * MiB;
constexpr size_t WS_UPS = 136 * MiB;
constexpr size_t WS_ACT = 312 * MiB;
constexpr size_t WS_END = 488 * MiB;

__device__ __forceinline__ void unpack8(const u32x4 w, float (&f)[8]) {
    f[0] = __uint_as_float(w.x << 16); f[1] = __uint_as_float(w.x & 0xffff0000u);
    f[2] = __uint_as_float(w.y << 16); f[3] = __uint_as_float(w.y & 0xffff0000u);
    f[4] = __uint_as_float(w.z << 16); f[5] = __uint_as_float(w.z & 0xffff0000u);
    f[6] = __uint_as_float(w.w << 16); f[7] = __uint_as_float(w.w & 0xffff0000u);
}
__device__ __forceinline__ u32x4 pack8(const float (&f)[8]) {
    u32x4 w; w.x = cvt_pk_bf16(f[0], f[1]); w.y = cvt_pk_bf16(f[2], f[3]); w.z = cvt_pk_bf16(f[4], f[5]); w.w = cvt_pk_bf16(f[6], f[7]); return w;
}
__device__ __forceinline__ float sigmoidf_(float v) { return __builtin_amdgcn_rcpf(1.0f + __builtin_amdgcn_exp2f(-v * LOG2E)); }
__device__ __forceinline__ float wave_sum(float v) {
#pragma unroll
    for (int o = 1; o < 64; o <<= 1) v += __shfl_xor(v, o);
    return v;
}

struct Sched1 {
    pg8::StaticOrder so;
    __device__ void init(int G, int c) { so.init(SEQ, DIN, G, c); }
    __device__ bool next(int i, Unit& u) const { return so.next(i, u); }
    __device__ __forceinline__ const char* pa(const Gemm& g, const Unit& u, size_t tstep) const { return u.pn == 17 ? (const char*)g.Bt + (size_t)17 * tstep : (const char*)g.A + (size_t)u.pm * tstep; }
    __device__ __forceinline__ const char* pb(const Gemm& g, const Unit& u, size_t tstep) const { return u.pn == 17 ? (const char*)g.A + (size_t)u.pm * tstep : (const char*)g.Bt + (size_t)u.pn * tstep; }
    __device__ __forceinline__ void a_ready(const Unit&) const {}
    __device__ __forceinline__ void done(const Unit&) const {}
};
struct Sched3 {
    pg8::StaticOrder so;
    __device__ void init(int G, int c) { so.init(SEQ, DM, G, c); }
    __device__ bool next(int i, Unit& u) const { if (!so.next(i >> 1, u)) return false; if (i & 1) { u.pm += 64; u.pn += 8; } return true; }
    __device__ __forceinline__ const char* pa(const Gemm& g, const Unit& u, size_t tstep) const { return (const char*)g.A + (size_t)u.pm * tstep; }
    __device__ __forceinline__ const char* pb(const Gemm& g, const Unit& u, size_t tstep) const { return (const char*)g.Bt + (size_t)u.pn * tstep; }
    __device__ __forceinline__ void a_ready(const Unit&) const {}
    __device__ __forceinline__ void done(const Unit&) const {}
};

struct Epi1 {
    static constexpr bool PERM = true, AFTER_DRAIN = false;
    bf16_t* z; bf16_t* vT; const float* rstd1; const float* cosT; const float* sinT; const float* bgate;
    __device__ __forceinline__ void operator()(const f32x4 (&acc)[2][2][4][2], const Unit& u, int wr, int wc, int fr, int fq) const {
        if (u.pn == 17) {
#pragma unroll
            for (int bj = 0; bj < 2; ++bj) {
                const int tok0 = u.pm * 256 + bj * 128 + wc * 32 + 8 * fq;
                const f32x4 r0 = *(const f32x4*)(rstd1 + tok0), r1 = *(const f32x4*)(rstd1 + tok0 + 4);
#pragma unroll
                for (int ai = 0; ai < 2; ++ai)
#pragma unroll
                    for (int m = 0; m < 4; ++m) {
                        const int d = ai * 128 + wr * 64 + m * 16 + fr;
                        const f32x4 v0 = acc[ai][bj][m][0] * r0, v1 = acc[ai][bj][m][1] * r1;
                        u32x4 w; w.x = cvt_pk_bf16(v0[0], v0[1]); w.y = cvt_pk_bf16(v0[2], v0[3]); w.z = cvt_pk_bf16(v1[0], v1[1]); w.w = cvt_pk_bf16(v1[2], v1[3]);
                        *(u32x4*)(vT + (size_t)d * SEQ + tok0) = w;
                    }
            }
            return;
        }
        const int kind = u.pn < 12 ? 0 : (u.pn < 17 ? 1 : 2);
#pragma unroll
        for (int ai = 0; ai < 2; ++ai)
#pragma unroll
            for (int m = 0; m < 4; ++m) {
                const int row = u.pm * 256 + ai * 128 + wr * 64 + m * 16 + fr;
                const float rs = rstd1[row];
                bf16_t* zr = z + (size_t)row * DIN;
#pragma unroll
                for (int bj = 0; bj < 2; ++bj) {
                    const int col0 = u.pn * 256 + bj * 128 + wc * 32 + 8 * fq;
                    f32x4 v0 = acc[ai][bj][m][0] * rs, v1 = acc[ai][bj][m][1] * rs;
                    if (kind == 1) {
                        const int hb = col0 & ~63, G4 = ((col0 & 63) >> 3) * 4;
                        const f32x4 cs = *(const f32x4*)(cosT + (size_t)row * 32 + G4), sn = *(const f32x4*)(sinT + (size_t)row * 32 + G4);
                        f32x4 o0 = v0 * cs - v1 * sn, o1 = v1 * cs + v0 * sn;
                        if (u.pn < 16) { o0 = o0 * QSCALE; o1 = o1 * QSCALE; }
                        u32x2 w0, w1; w0.x = cvt_pk_bf16(o0[0], o0[1]); w0.y = cvt_pk_bf16(o0[2], o0[3]); w1.x = cvt_pk_bf16(o1[0], o1[1]); w1.y = cvt_pk_bf16(o1[2], o1[3]);
                        *(u32x2*)(zr + hb + G4) = w0; *(u32x2*)(zr + hb + 32 + G4) = w1;
                    } else {
                        if (kind == 2) {
                            const f32x4 b0 = *(const f32x4*)(bgate + (col0 - C_GA)), b1 = *(const f32x4*)(bgate + (col0 - C_GA) + 4);
                            v0 = v0 + b0; v1 = v1 + b1;
#pragma unroll
                            for (int j = 0; j < 4; ++j) { v0[j] = sigmoidf_(v0[j]); v1[j] = sigmoidf_(v1[j]); }
                        }
                        u32x4 w; w.x = cvt_pk_bf16(v0[0], v0[1]); w.y = cvt_pk_bf16(v0[2], v0[3]); w.z = cvt_pk_bf16(v1[0], v1[1]); w.w = cvt_pk_bf16(v1[2], v1[3]);
                        *(u32x4*)(zr + col0) = w;
                    }
                }
            }
    }
};
struct Epi3 {
    static constexpr bool PERM = true, AFTER_DRAIN = false;
    const bf16_t* z; bf16_t* P; bf16_t* mb;
    __device__ __forceinline__ void operator()(const f32x4 (&acc)[2][2][4][2], const Unit& u, int wr, int wc, int fr, int fq) const {
        const bool second = u.pm >= 64; const int pm = u.pm & 63, pn = u.pn & 7;
#pragma unroll
        for (int ai = 0; ai < 2; ++ai)
#pragma unroll
            for (int m = 0; m < 4; ++m) {
                const int row = pm * 256 + ai * 128 + wr * 64 + m * 16 + fr;
#pragma unroll
                for (int bj = 0; bj < 2; ++bj) {
                    const int col0 = pn * 256 + bj * 128 + wc * 32 + 8 * fq;
                    float g[8]; unpack8(*(const u32x4*)(z + (size_t)row * DIN + (second ? C_GB : C_GA) + col0), g);
                    float v[8];
#pragma unroll
                    for (int j = 0; j < 4; ++j) { v[j] = acc[ai][bj][m][0][j] * g[j]; v[4 + j] = acc[ai][bj][m][1][j] * g[4 + j]; }
                    if (second) {
                        float p[8]; unpack8(*(const u32x4*)(P + (size_t)row * DM + col0), p);
#pragma unroll
                        for (int j = 0; j < 8; ++j) v[j] += p[j];
                        *(u32x4*)(mb + (size_t)row * DM + col0) = pack8(v);
                    } else {
                        *(u32x4*)(P + (size_t)row * DM + col0) = pack8(v);
                    }
                }
            }
    }
};
struct EpiRes {
    static constexpr bool PERM = true, AFTER_DRAIN = false;
    const float* hin; float* hout; bf16_t* hb; float* ssq;
    __device__ __forceinline__ void operator()(const f32x4 (&acc)[2][2][4][2], const Unit& u, int wr, int wc, int fr, int fq) const {
#pragma unroll
        for (int ai = 0; ai < 2; ++ai)
#pragma unroll
            for (int m = 0; m < 4; ++m) {
                const int row = u.pm * 256 + ai * 128 + wr * 64 + m * 16 + fr;
                float ss = 0.f;
#pragma unroll
                for (int bj = 0; bj < 2; ++bj) {
                    const int col0 = u.pn * 256 + bj * 128 + wc * 32 + 8 * fq;
                    const size_t off = (size_t)row * DM + col0;
                    const f32x4 h0 = *(const f32x4*)(hin + off) + acc[ai][bj][m][0], h1 = *(const f32x4*)(hin + off + 4) + acc[ai][bj][m][1];
                    *(f32x4*)(hout + off) = h0; *(f32x4*)(hout + off + 4) = h1;
                    ss += (h0[0] * h0[0] + h0[1] * h0[1]) + (h0[2] * h0[2] + h0[3] * h0[3]) + (h1[0] * h1[0] + h1[1] * h1[1]) + (h1[2] * h1[2] + h1[3] * h1[3]);
                    if (hb) { u32x4 w; w.x = cvt_pk_bf16(h0[0], h0[1]); w.y = cvt_pk_bf16(h0[2], h0[3]); w.z = cvt_pk_bf16(h1[0], h1[1]); w.w = cvt_pk_bf16(h1[2], h1[3]); *(u32x4*)(hb + off) = w; }
                }
                ss += __shfl_xor(ss, 16); ss += __shfl_xor(ss, 32);
                if (fq == 0) unsafeAtomicAdd(ssq + row, ss);
            }
    }
};
struct Epi5 {
    static constexpr bool PERM = true, AFTER_DRAIN = false;
    bf16_t* ups; const float* ssq2;
    __device__ __forceinline__ void operator()(const f32x4 (&acc)[2][2][4][2], const Unit& u, int wr, int wc, int fr, int fq) const {
#pragma unroll
        for (int ai = 0; ai < 2; ++ai)
#pragma unroll
            for (int m = 0; m < 4; ++m) {
                const int row = u.pm * 256 + ai * 128 + wr * 64 + m * 16 + fr;
                const float rs = 1.0f / sqrtf(ssq2[row] * (1.0f / DM) + EPS);
#pragma unroll
                for (int bj = 0; bj < 2; ++bj) {
                    const int col0 = u.pn * 256 + bj * 128 + wc * 32 + 8 * fq;
                    const f32x4 v0 = acc[ai][bj][m][0] * rs, v1 = acc[ai][bj][m][1] * rs;
                    u32x4 w; w.x = cvt_pk_bf16(v0[0], v0[1]); w.y = cvt_pk_bf16(v0[2], v0[3]); w.z = cvt_pk_bf16(v1[0], v1[1]); w.w = cvt_pk_bf16(v1[2], v1[3]);
                    *(u32x4*)(ups + (size_t)row * (2 * FFH) + col0) = w;
                }
            }
    }
};

enum { RM_ID = 0, RM_WIN = 1, RM_UP = 2 };
template <int RM> __device__ __forceinline__ int rowmap(int n) {
    if (RM == RM_WIN) { if (n >= C_Q && n < C_V) { const int base = n & ~63, d = n & 63; return base + 8 * ((d & 31) >> 2) + 4 * (d >> 5) + (d & 3); } return n; }
    if (RM == RM_UP) { const int isgv = n >= DFF ? 1 : 0; const int cc = n - DFF * isgv; const int half = cc >= FFH ? 1 : 0; const int j = cc - FFH * half; return 2 * FFH * half + FFH * isgv + j; }
    return n;
}
template <int RM> __device__ __forceinline__ void p0_transpose_item(const float* W, const float* gk, int K, int N, bf16_t* WT, int row_off, LAS float* scr, int item, int lane) {
    const int nblk = N / 64, kb = item / nblk, nb = item - kb * nblk, k0 = 64 * kb, n0 = 64 * nb;
    const int r = lane >> 4, n4 = (lane & 15) * 4;
    f32x4 v[16];
#pragma unroll
    for (int i = 0; i < 16; ++i) v[i] = *(const f32x4*)(W + (size_t)(k0 + 4 * i + r) * N + n0 + n4);
#pragma unroll
    for (int i = 0; i < 16; ++i) {
        const int kk = 4 * i + r; f32x4 w = v[i]; if (gk) w = w * gk[k0 + kk];
        LAS float* d = scr + kk * 65 + n4; d[0] = w[0]; d[1] = w[1]; d[2] = w[2]; d[3] = w[3];
    }
    asm volatile("s_waitcnt lgkmcnt(0)" ::: "memory");
    const int c = lane & 7;
#pragma unroll
    for (int j = 0; j < 8; ++j) { const int n = (lane >> 3) + 8 * j; const LAS float* s = scr + (8 * c) * 65 + n;
        u32x4 o; o.x = cvt_pk_bf16(s[0 * 65], s[1 * 65]); o.y = cvt_pk_bf16(s[2 * 65], s[3 * 65]); o.z = cvt_pk_bf16(s[4 * 65], s[5 * 65]); o.w = cvt_pk_bf16(s[6 * 65], s[7 * 65]);
        *(u32x4*)(WT + (size_t)(row_off + rowmap<RM>(n0 + n)) * K + k0 + 8 * c) = o; }
    asm volatile("s_waitcnt lgkmcnt(0)" ::: "memory");
}

struct Args { const float* in[15]; float* out; unsigned char* ws; int ph_lo, ph_hi; };

__device__ __forceinline__ void phase_prologue(const Args& a, LAS unsigned char* lds, int tid, int lane, int wave, int vcu, int G) {
    unsigned char* ws = a.ws;
    LAS float* scr = (LAS float*)(lds + wave * 16640);
    const int gw = vcu * NWAVES + wave, NGW = G * NWAVES;
    constexpr int I_IN = (DM / 64) * (DIN / 64), I_OA = (DCONV / 64) * (DM / 64), I_OB = (DATT / 64) * (DM / 64), I_MIX = (DM / 64) * (DM / 64), I_UP = (DM / 64) * (2 * DFF / 64), I_DN = (DFF / 64) * (DM / 64);
    constexpr int NITEMS = I_IN + I_OA + I_OB + I_MIX + I_UP + I_DN;
    for (int it = gw; it < NITEMS; it += NGW) {
        int r = it;
        if (r < I_IN) { p0_transpose_item<RM_WIN>(a.in[2], a.in[1], DM, DIN, (bf16_t*)(ws + WS_WIN), 0, scr, r, lane); continue; } r -= I_IN;
        if (r < I_OA) { p0_transpose_item<RM_ID>(a.in[5], nullptr, DCONV, DM, (bf16_t*)(ws + WS_BT3), 0, scr, r, lane); continue; } r -= I_OA;
        if (r < I_OB) { p0_transpose_item<RM_ID>(a.in[7], nullptr, DATT, DM, (bf16_t*)(ws + WS_BT3), DM, scr, r, lane); continue; } r -= I_OB;
        if (r < I_MIX) { p0_transpose_item<RM_ID>(a.in[8], nullptr, DM, DM, (bf16_t*)(ws + WS_WMIX), 0, scr, r, lane); continue; } r -= I_MIX;
        if (r < I_UP) { p0_transpose_item<RM_UP>(a.in[10], a.in[9], DM, 2 * DFF, (bf16_t*)(ws + WS_WUP), 0, scr, r, lane); continue; } r -= I_UP;
        p0_transpose_item<RM_ID>(a.in[13], nullptr, DFF, DM, (bf16_t*)(ws + WS_WDOWN), 0, scr, r, lane);
    }
    const float* x = a.in[0]; bf16_t* xb = (bf16_t*)(ws + WS_XB); float* rstd1 = (float*)(ws + WS_RSTD1);
    for (int m = gw; m < SEQ; m += NGW) {
        const f32x4* xr = (const f32x4*)(x + (size_t)m * DM) + lane; f32x4 v[8]; float s = 0.f;
#pragma unroll
        for (int j = 0; j < 8; ++j) { v[j] = xr[64 * j]; s += (v[j][0] * v[j][0] + v[j][1] * v[j][1]) + (v[j][2] * v[j][2] + v[j][3] * v[j][3]); }
        s = wave_sum(s);
        u32x2* o8 = (u32x2*)(xb + (size_t)m * DM) + lane;
#pragma unroll
        for (int j = 0; j < 8; ++j) { u32x2 w; w.x = cvt_pk_bf16(v[j][0], v[j][1]); w.y = cvt_pk_bf16(v[j][2], v[j][3]); o8[64 * j] = w; }
        if (lane == 0) rstd1[m] = 1.0f / sqrtf(s * (1.0f / DM) + EPS);
    }
    const int gt = vcu * NTHREADS + tid, NGT = G * NTHREADS;
    float* cosT = (float*)(ws + WS_COS); float* sinT = (float*)(ws + WS_SIN);
    for (int idx = gt; idx < SEQ * 32; idx += NGT) {
        const int t = idx >> 5, i = idx & 31;
        double f = 1.0; for (int k = 0; k < i; ++k) f *= 0.7498942093324559;
        const float inv = (float)f; const float angf = (float)t * inv;
        const double ang = (double)angf;
        const double kq = __builtin_rint(ang * 0.6366197723675814);
        double y = __builtin_fma(-kq, 1.5707963267948966, ang); y = __builtin_fma(-kq, 6.123233995736766e-17, y);
        const double y2 = y * y;
        double sp = -1.0 / 1307674368000.0; sp = sp * y2 + 1.0 / 6227020800.0; sp = sp * y2 - 1.0 / 39916800.0; sp = sp * y2 + 1.0 / 362880.0; sp = sp * y2 - 1.0 / 5040.0; sp = sp * y2 + 1.0 / 120.0; sp = sp * y2 - 1.0 / 6.0; sp = sp * y2 + 1.0; sp = sp * y;
        double cp = 1.0 / 20922789888000.0; cp = cp * y2 - 1.0 / 87178291200.0; cp = cp * y2 + 1.0 / 479001600.0; cp = cp * y2 - 1.0 / 3628800.0; cp = cp * y2 + 1.0 / 40320.0; cp = cp * y2 - 1.0 / 720.0; cp = cp * y2 + 1.0 / 24.0; cp = cp * y2 - 0.5; cp = cp * y2 + 1.0;
        const int q = ((int)kq) & 3;
        const double sv = (q == 0) ? sp : (q == 1) ? cp : (q == 2) ? -sp : -cp;
        const double cv = (q == 0) ? cp : (q == 1) ? -sp : (q == 2) ? -cp : sp;
        cosT[idx] = (float)cv; sinT[idx] = (float)sv;
    }
    float* ssq2 = (float*)(ws + WS_SSQ2); float* ssq3 = (float*)(ws + WS_SSQ3);
    for (int idx = gt; idx < SEQ; idx += NGT) { ssq2[idx] = 0.f; ssq3[idx] = 0.f; }
}

__device__ __forceinline__ void load_cv(const bf16_t* z, int t, int c0, float (&cv)[8]) {
    if (t < 0 || t >= SEQ) {
#pragma unroll
        for (int j = 0; j < 8; ++j) cv[j] = 0.f;
        return;
    }
    float c[8], v[8]; unpack8(*(const u32x4*)(z + (size_t)t * DIN + C_CA + c0), c); unpack8(*(const u32x4*)(z + (size_t)t * DIN + C_VA + c0), v);
#pragma unroll
    for (int j = 0; j < 8; ++j) cv[j] = c[j] * v[j];
}
__device__ __forceinline__ void phase_mixer(const Args& a, int lane, int gw, int NGW) {
    const bf16_t* z = (const bf16_t*)(a.ws + WS_Z); bf16_t* ya = (bf16_t*)a.out; const float* cw = a.in[4];
    for (int it = gw; it < (SEQ / 16) * 2; it += NGW) {
        const int t0 = (it >> 1) * 16, c0 = (it & 1) * 512 + 8 * lane;
        float w0[8], w1[8], w2[8];
#pragma unroll
        for (int j = 0; j < 8; ++j) { w0[j] = cw[c0 + j]; w1[j] = cw[DCONV + c0 + j]; w2[j] = cw[2 * DCONV + c0 + j]; }
        float prev[8], cur[8], nxt[8];
        load_cv(z, t0 - 1, c0, prev); load_cv(z, t0, c0, cur);
        for (int t = t0; t < t0 + 16; ++t) {
            load_cv(z, t + 1, c0, nxt);
            float b[8]; unpack8(*(const u32x4*)(z + (size_t)t * DIN + C_BA + c0), b);
            float o[8];
#pragma unroll
            for (int j = 0; j < 8; ++j) { o[j] = b[j] * (w0[j] * prev[j] + w1[j] * cur[j] + w2[j] * nxt[j]); prev[j] = cur[j]; cur[j] = nxt[j]; }
            *(u32x4*)(ya + (size_t)t * DCONV + c0) = pack8(o);
        }
    }
}

constexpr int KROW = 144, VROW = 656, KWIN = 320, LDS_KB = KWIN * KROW;
__device__ __forceinline__ void attn_unit(LAS unsigned char* lds, const bf16_t* z, const bf16_t* vT, bf16_t* att, const float* sink, int kh, int qb, int tid) {
    asm volatile("" : "+v"(tid));
    const int lane = tid & 63, wid = __builtin_amdgcn_readfirstlane(tid >> 6), l31 = lane & 31, hi = lane >> 5;
    const int q0 = qb * 64;
#pragma unroll
    for (int i = 0; i < 5; ++i) {
        const int id = tid + 512 * i, r = id >> 3, ch = id & 7, t = q0 - 128 + r;
        u32x4 v = (u32x4){0u, 0u, 0u, 0u};
        if (t >= 0 && t < SEQ) v = *(const u32x4*)(z + (size_t)t * DIN + C_K + 64 * kh + 8 * ch);
        *(LAS u32x4*)(lds + r * KROW + ch * 16) = v;
    }
#pragma unroll
    for (int i = 0; i < 5; ++i) {
        const int id = tid + 512 * i, d = id / 40, ch = id - d * 40, t = q0 - 128 + 8 * ch;
        u32x4 v = (u32x4){0u, 0u, 0u, 0u};
        if (t >= 0 && t < SEQ) v = *(const u32x4*)(vT + (size_t)(64 * kh + d) * SEQ + t);
        *(LAS u32x4*)(lds + LDS_KB + d * VROW + ch * 16) = v;
    }
    __syncthreads();
    const int g = wid >> 1, sb = wid & 1, head = 4 * kh + g, q0w = q0 + 32 * sb;
    bf16x8 qr[4];
#pragma unroll
    for (int ds = 0; ds < 4; ++ds) qr[ds] = *(const bf16x8*)(z + (size_t)(q0w + l31) * DIN + C_Q + head * 64 + 16 * ds + 8 * hi);
    const int pi = (l31 & 0x13) | ((l31 & 4) << 1) | ((l31 & 8) >> 1);
    f32x16 s[9];
#pragma unroll
    for (int tl = 0; tl < 9; ++tl) {
        const LAS unsigned char* kp = lds + (32 * (sb + tl) + pi) * KROW + 16 * hi;
        f32x16 acc = (f32x16){0.f, 0.f, 0.f, 0.f, 0.f, 0.f, 0.f, 0.f, 0.f, 0.f, 0.f, 0.f, 0.f, 0.f, 0.f, 0.f};
#pragma unroll
        for (int ds = 0; ds < 4; ++ds) { const bf16x8 kf = *(const LAS bf16x8*)(kp + 32 * ds); acc = __builtin_amdgcn_mfma_f32_32x32x16_bf16(kf, qr[ds], acc, 0, 0, 0); }
        s[tl] = acc;
    }
    const float sinkl = sink[head] * LOG2E;
    float mx = sinkl;
    const int qpos = q0w + l31;
#pragma unroll
    for (int tl = 0; tl < 9; ++tl)
#pragma unroll
        for (int r = 0; r < 16; ++r) {
            const int kpos = q0w - 128 + 32 * tl + 16 * (r >> 3) + 8 * hi + (r & 7);
            const int dlt = kpos - qpos;
            const bool ok = (dlt >= -128) && (dlt <= 128) && (kpos >= 0) && (kpos < SEQ);
            const float v = ok ? s[tl][r] : -INFINITY;
            s[tl][r] = v; mx = fmaxf(mx, v);
        }
    mx = fmaxf(mx, __shfl_xor(mx, 32));
    float sum = 0.f;
#pragma unroll
    for (int tl = 0; tl < 9; ++tl)
#pragma unroll
        for (int r = 0; r < 16; ++r) { const float p = __builtin_amdgcn_exp2f(s[tl][r] - mx); s[tl][r] = p; sum += p; }
    sum += __shfl_xor(sum, 32);
    const float inv = 1.0f / (sum + __builtin_amdgcn_exp2f(sinkl - mx));
    f32x16 o[2];
    o[0] = (f32x16){0.f, 0.f, 0.f, 0.f, 0.f, 0.f, 0.f, 0.f, 0.f, 0.f, 0.f, 0.f, 0.f, 0.f, 0.f, 0.f}; o[1] = o[0];
#pragma unroll
    for (int tl = 0; tl < 9; ++tl)
#pragma unroll
        for (int s2 = 0; s2 < 2; ++s2) {
            u32x4 pw; pw.x = cvt_pk_bf16(s[tl][8 * s2 + 0], s[tl][8 * s2 + 1]); pw.y = cvt_pk_bf16(s[tl][8 * s2 + 2], s[tl][8 * s2 + 3]);
            pw.z = cvt_pk_bf16(s[tl][8 * s2 + 4], s[tl][8 * s2 + 5]); pw.w = cvt_pk_bf16(s[tl][8 * s2 + 6], s[tl][8 * s2 + 7]);
            const bf16x8 pb = __builtin_bit_cast(bf16x8, pw);
#pragma unroll
            for (int db = 0; db < 2; ++db) {
                const bf16x8 vf = *(const LAS bf16x8*)(lds + LDS_KB + (32 * db + l31) * VROW + (32 * (sb + tl) + 16 * s2 + 8 * hi) * 2);
                o[db] = __builtin_amdgcn_mfma_f32_32x32x16_bf16(vf, pb, o[db], 0, 0, 0);
            }
        }
    bf16_t* orow = att + (size_t)(q0w + l31) * DATT + head * 64;
#pragma unroll
    for (int db = 0; db < 2; ++db)
#pragma unroll
        for (int rg = 0; rg < 4; ++rg) {
            u32x2 w; w.x = cvt_pk_bf16(o[db][4 * rg + 0] * inv, o[db][4 * rg + 1] * inv); w.y = cvt_pk_bf16(o[db][4 * rg + 2] * inv, o[db][4 * rg + 3] * inv);
            *(u32x2*)(orow + 32 * db + 8 * rg + 4 * hi) = w;
        }
    __syncthreads();
}

__device__ __forceinline__ void load_up(const bf16_t* ups, int t, int j0, float (&ua)[8], float (&ug)[8]) {
    if (t < 0 || t >= SEQ) {
#pragma unroll
        for (int j = 0; j < 8; ++j) { ua[j] = 0.f; ug[j] = 0.f; }
        return;
    }
    unpack8(*(const u32x4*)(ups + (size_t)t * (2 * FFH) + j0), ua); unpack8(*(const u32x4*)(ups + (size_t)t * (2 * FFH) + FFH + j0), ug);
}
__device__ __forceinline__ void phase_ffnconv(const Args& a, int half, int lane, int gw, int NGW) {
    const bf16_t* ups = (const bf16_t*)(a.ws + WS_UPS); bf16_t* act = (bf16_t*)(a.ws + WS_ACT); const float* cw = a.in[11]; const float* cb = a.in[12];
    for (int it = gw; it < (SEQ / 16) * 6; it += NGW) {
        const int run = it / 6, cg6 = it - run * 6, chunk = 64 * cg6 + lane, t0 = run * 16;
        if (chunk >= FFH / 8) continue;
        const int j0 = 8 * chunk, ca = FFH * half + j0;
        float wa0[8], wa1[8], wa2[8], ba[8], wg0[8], wg1[8], wg2[8], bg[8];
#pragma unroll
        for (int j = 0; j < 8; ++j) {
            wa0[j] = cw[ca + j]; wa1[j] = cw[2 * DFF + ca + j]; wa2[j] = cw[4 * DFF + ca + j]; ba[j] = cb[ca + j];
            wg0[j] = cw[DFF + ca + j]; wg1[j] = cw[3 * DFF + ca + j]; wg2[j] = cw[5 * DFF + ca + j]; bg[j] = cb[DFF + ca + j];
        }
        float pa_[8], pg_[8], ca_[8], cg_[8], na_[8], ng_[8];
        load_up(ups, t0 - 1, j0, pa_, pg_); load_up(ups, t0, j0, ca_, cg_);
        for (int t = t0; t < t0 + 16; ++t) {
            load_up(ups, t + 1, j0, na_, ng_);
            float o[8];
#pragma unroll
            for (int j = 0; j < 8; ++j) {
                const float A = wa0[j] * pa_[j] + wa1[j] * ca_[j] + wa2[j] * na_[j] + ba[j];
                const float Gv = wg0[j] * pg_[j] + wg1[j] * cg_[j] + wg2[j] * ng_[j] + bg[j];
                o[j] = A * sigmoidf_(A) * Gv;
                pa_[j] = ca_[j]; ca_[j] = na_[j]; pg_[j] = cg_[j]; cg_[j] = ng_[j];
            }
            *(u32x4*)(act + (size_t)t * DFF + ca) = pack8(o);
        }
    }
}

constexpr size_t WS_BAR = 196608 + 256;
__device__ __forceinline__ void grid_barrier(unsigned* cnt, unsigned target) {
    asm volatile("s_waitcnt vmcnt(0)" ::: "memory");
    __syncthreads();
    if (threadIdx.x == 0) {
        __builtin_amdgcn_fence(__ATOMIC_RELEASE, "agent");
        asm volatile("s_waitcnt vmcnt(0)" ::: "memory");
        __hip_atomic_fetch_add(cnt, 1u, __ATOMIC_RELAXED, __HIP_MEMORY_SCOPE_AGENT);
        while (__hip_atomic_load(cnt, __ATOMIC_RELAXED, __HIP_MEMORY_SCOPE_AGENT) < target) __builtin_amdgcn_s_sleep(2);
        __builtin_amdgcn_fence(__ATOMIC_ACQUIRE, "agent");
        asm volatile("s_waitcnt vmcnt(0)" ::: "memory");
    }
    __syncthreads();
}

__global__ void __launch_bounds__(NTHREADS, 2) fwd_megakernel(Args args) {
    extern __shared__ __attribute__((aligned(16))) unsigned char lds_raw[];
    LAS unsigned char* lds = (LAS unsigned char*)lds_raw;
    const int tid = threadIdx.x, lane = tid & 63, wave = __builtin_amdgcn_readfirstlane(tid >> 6);
    const int G = gridDim.x, bx = blockIdx.x;
    const int vcu = (G % 8 == 0) ? (bx % 8) * (G / 8) + bx / 8 : bx;
    const int gw = vcu * NWAVES + wave, NGW = G * NWAVES;
    unsigned char* ws = args.ws;
    const int lo = args.ph_lo, hi = args.ph_hi;
#define IN(k) (lo <= (k) && (k) < hi)
    unsigned* barw = (unsigned*)(ws + WS_BAR); unsigned nbar = 0;
#define SEAM(k) do { if (IN(k) && IN((k) + 1)) { nbar += (unsigned)G; grid_barrier(barw, nbar); } } while (0)

    if (IN(0)) {
        if (bx == 0 && tid == 0) __hip_atomic_store(barw, 0u, __ATOMIC_RELAXED, __HIP_MEMORY_SCOPE_AGENT);
        phase_prologue(args, lds, tid, lane, wave, vcu, G);
#ifdef PROBE_DUP_P0
        __syncthreads(); phase_prologue(args, lds, tid, lane, wave, vcu, G);
#endif
    }
    if (IN(0) && IN(1)) { cg::this_grid().sync(); }
    if (IN(1)) {
        Gemm g{(const bf16_t*)(ws + WS_XB), (const bf16_t*)(ws + WS_WIN), SEQ, DIN, DM}; Sched1 S; S.init(G, bx);
        Epi1 E{(bf16_t*)(ws + WS_Z), (bf16_t*)(ws + WS_VT), (const float*)(ws + WS_RSTD1), (const float*)(ws + WS_COS), (const float*)(ws + WS_SIN), args.in[3]};
        pg8::gemm_phase<Epi1, Sched1, true, true>(lds, g, S, E);
    }
    SEAM(1);
    if (IN(2)) {
        phase_mixer(args, lane, gw, NGW);
        const bf16_t* z = (const bf16_t*)(ws + WS_Z); const bf16_t* vT = (const bf16_t*)(ws + WS_VT); bf16_t* att = (bf16_t*)args.out + (size_t)SEQ * DCONV;
        for (int u = vcu; u < NKV * (SEQ / 64); u += G) attn_unit(lds, z, vT, att, args.in[6], u & 3, u >> 2, tid);
#ifdef PROBE_DUP_ATT
        for (int u = vcu; u < NKV * (SEQ / 64); u += G) attn_unit(lds, z, vT, att, args.in[6], u & 3, u >> 2, tid);
#endif
#ifdef PROBE_DUP_MIX
        phase_mixer(args, lane, gw, NGW);
#endif
    }
    SEAM(2);
    if (IN(3)) {
        Gemm g{(const bf16_t*)args.out, (const bf16_t*)(ws + WS_BT3), 2 * SEQ, 2 * DM, DCONV}; Sched3 S; S.init(G, bx);
        Epi3 E{(const bf16_t*)(ws + WS_Z), (bf16_t*)args.out + (size_t)2 * SEQ * DCONV, (bf16_t*)(ws + WS_MB)};
        pg8::gemm_phase<Epi3, Sched3, true, true>(lds, g, S, E);
    }
    SEAM(3);
    if (IN(4)) {
        Gemm g{(const bf16_t*)(ws + WS_MB), (const bf16_t*)(ws + WS_WMIX), SEQ, DM, DM}; pg8::StaticOrder S; S.init(SEQ, DM, G, bx);
        EpiRes E{args.in[0], args.out, (bf16_t*)(ws + WS_H1B), (float*)(ws + WS_SSQ2)};
        pg8::gemm_phase<EpiRes, pg8::StaticOrder, true, true>(lds, g, S, E);
    }
    SEAM(4);
#pragma unroll 1
    for (int half = 0; half < 2; ++half) {
        if (IN(5 + 2 * half)) {
            Gemm g{(const bf16_t*)(ws + WS_H1B), (const bf16_t*)(ws + WS_WUP) + (size_t)half * (2 * FFH) * DM, SEQ, 2 * FFH, DM}; pg8::StaticOrder S; S.init(SEQ, 2 * FFH, G, bx);
            Epi5 E{(bf16_t*)(ws + WS_UPS), (const float*)(ws + WS_SSQ2)};
            pg8::gemm_phase<Epi5, pg8::StaticOrder, true, true>(lds, g, S, E);
#ifdef PROBE_DUP_G5
            if (half == 0) { __syncthreads(); pg8::gemm_phase<Epi5, pg8::StaticOrder, true, true>(lds, g, S, E); }
#endif
        }
        SEAM(5 + 2 * half);
        if (IN(6 + 2 * half)) { phase_ffnconv(args, half, lane, gw, NGW);
#ifdef PROBE_DUP_CONV
            if (half == 0) phase_ffnconv(args, half, lane, gw, NGW);
#endif
        }
        SEAM(6 + 2 * half);
    }
    if (IN(9)) {
        Gemm g{(const bf16_t*)(ws + WS_ACT), (const bf16_t*)(ws + WS_WDOWN), SEQ, DM, DFF}; pg8::StaticOrder S; S.init(SEQ, DM, G, bx);
        EpiRes E{args.out, args.out, nullptr, (float*)(ws + WS_SSQ3)};
        pg8::gemm_phase<EpiRes, pg8::StaticOrder, true, true>(lds, g, S, E);
    }
    SEAM(9);
#ifdef PROBE_BARS
    for (int rep = 0; rep < 10; ++rep) { nbar += (unsigned)G; grid_barrier(barw, nbar); }
#endif
    if (IN(10)) {
        const float* ssq3 = (const float*)(ws + WS_SSQ3); const float* gf = args.in[14];
        for (int m = gw; m < SEQ; m += NGW) {
            const float rs = 1.0f / sqrtf(ssq3[m] * (1.0f / DM) + EPS);
            f32x4* xr = (f32x4*)(args.out + (size_t)m * DM) + lane; const f32x4* gr = (const f32x4*)gf + lane;
#pragma unroll
            for (int j = 0; j < 8; ++j) { const f32x4 v = xr[64 * j] * rs * gr[64 * j]; xr[64 * j] = v; }
        }
    }
#undef IN
#undef SEAM
}

constexpr int N_PHASES = 11;
extern "C" void kernel_launch(void* const* d_in, const int* in_sizes, int n_in, void* d_out, int out_size, void* d_ws, size_t ws_size, hipStream_t stream) {
    static int grid = 0;
    if (grid == 0) {
        if (n_in != 15 || in_sizes[0] != SEQ * DM || out_size != SEQ * DM || ws_size < WS_END) { fprintf(stderr, "kernel_launch: unexpected shapes / workspace (n_in %d, in0 %d, out %d, ws %zu)\n", n_in, n_in > 0 ? in_sizes[0] : -1, out_size, ws_size); grid = -1; return; }
        int dev = 0, cus = 0;
        if (hipGetDevice(&dev) != hipSuccess || hipDeviceGetAttribute(&cus, hipDeviceAttributeMultiprocessorCount, dev) != hipSuccess) { grid = -1; return; }
        if (hipFuncSetAttribute((const void*)fwd_megakernel, hipFuncAttributeMaxDynamicSharedMemorySize, LDS_BYTES) != hipSuccess) { fprintf(stderr, "kernel_launch: hipFuncSetAttribute failed\n"); grid = -1; return; }
        int per_cu = 0;
        if (hipOccupancyMaxActiveBlocksPerMultiprocessor(&per_cu, (const void*)fwd_megakernel, NTHREADS, LDS_BYTES) != hipSuccess || per_cu < 1) { fprintf(stderr, "kernel_launch: occupancy query says %d blocks per CU\n", per_cu); (void)hipGetLastError(); }
        grid = cus;
    }
    if (grid < 0) return;
    Args a{};
    for (int i = 0; i < 15; ++i) a.in[i] = (const float*)d_in[i];
    a.out = (float*)d_out; a.ws = (unsigned char*)d_ws;
#if MK_N_LAUNCHES == 1
    a.ph_lo = 0; a.ph_hi = N_PHASES;
    void* kargs[] = {&a};
    hipError_t e = hipLaunchCooperativeKernel((const void*)fwd_megakernel, dim3(grid), dim3(NTHREADS), kargs, LDS_BYTES, stream);
    if (e != hipSuccess) fprintf(stderr, "kernel_launch: cooperative launch failed: %s (grid %d)\n", hipGetErrorString(e), grid);
#else
    for (int ph = 0; ph < N_PHASES; ++ph) {
        a.ph_lo = ph; a.ph_hi = ph + 1;
        hipLaunchKernelGGL(fwd_megakernel, dim3(grid), dim3(NTHREADS), LDS_BYTES, stream, a);
    }
#endif
}
```

```cpp
#include <hip/hip_runtime.h>
#include <hip/hip_cooperative_groups.h>
#include <cstdio>
#include <cstdint>
namespace cg = cooperative_groups;
#ifndef MK_N_LAUNCHES
#define MK_N_LAUNCHES 1
#endif

namespace pg8 {
#define PG8_LAS __attribute__((address_space(3)))
typedef unsigned short bf16_t;
typedef short bf16x8 __attribute__((ext_vector_type(8)));
typedef float f32x4 __attribute__((ext_vector_type(4)));
typedef unsigned u32x4 __attribute__((ext_vector_type(4)));
constexpr int BM = 256, BK = 64, HALF = 128, HTB = HALF * BK * 2  , STAGE_BYTES = 8 * HTB, NXCD = 8, WGM = 8;

__host__ __device__ __forceinline__ int lds_byte(int r, int c) { const int st = (r >> 4) * 2 + (c >> 5), rr = r & 15, cc = c & 31, ob = rr * 64 + cc * 2; return st * 1024 + (ob ^ (((ob >> 9) & 1) << 5)); }
__host__ __device__ __forceinline__ void stage_rc(int b, int& R, int& C) { const int st = b / 1024, sb = b % 1024, swz = sb ^ (((sb >> 9) & 1) << 5); R = (st >> 1) * 16 + swz / 64; C = (st & 1) * 32 + (swz % 64) / 2; }
__host__ __device__ __forceinline__ int perm32(int rho) { const int n = rho >> 4, i = rho & 15; return 8 * (i >> 2) + 4 * n + (i & 3); }

struct Unit { int pm, pn; };
struct Gemm { const bf16_t* A; const bf16_t* Bt; int M, N, K; };

struct StaticOrder {
    int nM, nN, nwg, G, c;
    __host__ __device__ void init(int M, int N, int G_, int c_) { nM = M / BM; nN = N / BM; nwg = nM * nN; G = G_; c = c_; }
    __host__ __device__ bool next(int i, Unit& u) const {
        const long L = (long)i * G + c; if (L >= nwg) return false;
        int wgid = (int)L; { const int q = nwg / NXCD, r = nwg % NXCD, xcd = wgid % NXCD, off = wgid / NXCD; wgid = (xcd < r ? xcd * (q + 1) : r * (q + 1) + (xcd - r) * q) + off; }
        const int nig = WGM * nN, gid = wgid / nig, fm = gid * WGM, gsz = (nM - fm) < WGM ? (nM - fm) : WGM;
        u.pm = fm + ((wgid % nig) % gsz); u.pn = (wgid % nig) / gsz; return true;
    }
    __device__ __forceinline__ const char* pa(const Gemm& g, const Unit& u, size_t tstep) const { return (const char*)g.A + (size_t)u.pm * tstep; }
    __device__ __forceinline__ const char* pb(const Gemm& g, const Unit& u, size_t tstep) const { return (const char*)g.Bt + (size_t)u.pn * tstep; }
    __device__ __forceinline__ void a_ready(const Unit&) const {}
    __device__ __forceinline__ void done(const Unit&) const {}
};

__device__ __forceinline__ unsigned cvt_pk_bf16(float lo, float hi) { unsigned r; asm volatile("v_cvt_pk_bf16_f32 %0, %1, %2" : "=v"(r) : "v"(lo), "v"(hi)); return r; }
typedef float f32x2 __attribute__((ext_vector_type(2)));
template <class Epi, class Sched, bool ALIGN_EPI = false, bool SP2 = false>
__device__ __forceinline__ void gemm_phase(PG8_LAS unsigned char* lds, const Gemm g, const Sched& S, const Epi& E) {
    const int tid = threadIdx.x, wid = __builtin_amdgcn_readfirstlane(tid >> 6), lane = tid & 63, wr = wid >> 2, wc = wid & 3, fr = lane & 15, fq = lane >> 4;
    const int K = g.K, nt = K / BK;
    unsigned voffA[2], voffB[2];
#pragma unroll
    for (int i = 0; i < 2; ++i) { int R, C; stage_rc(tid * 16 + i * 8192, R, C); const int Rb = Epi::PERM ? ((R & ~31) + perm32(R & 31)) : R;
        const int Ra = Epi::PERMA ? ((R & ~63) + 4 * (R & 15) + ((R >> 4) & 3)) : R;
        voffA[i] = (unsigned)(Ra * K + C) * 2u; voffB[i] = (unsigned)(Rb * K + C) * 2u; }
    const size_t kstep = (size_t)(BK * 2);
    const size_t hstep = (size_t)HALF * K * 2;
    const size_t tstep = 2 * hstep;
    const unsigned ldsw = (unsigned)wid * 1024u;
    const int aoff = lds_byte(wr * 64 + fr, fq * 8), boff = lds_byte(wc * 32 + fr, fq * 8);
#define PG8_SA(b, h) (((b) * 2 + (h)) * HTB)
#define PG8_SB(b, h) ((4 + (b) * 2 + (h)) * HTB)
#define PG8_STAGE(bufoff, gbase, voff) do { _Pragma("unroll") for (int _i = 0; _i < 2; ++_i) \
        __builtin_amdgcn_global_load_lds((const unsigned*)((const char*)(gbase) + (voff)[_i]), (PG8_LAS unsigned*)(lds + (bufoff) + ldsw + _i * 8192), 16, 0, 0); } while (0)
#define PG8_LDA(dst, b, h) do { _Pragma("unroll") for (int m = 0; m < 4; ++m) _Pragma("unroll") for (int k = 0; k < 2; ++k) dst[m][k] = *(const PG8_LAS bf16x8*)(lds + PG8_SA(b, h) + aoff + m * 2048 + k * 1024); } while (0)
#define PG8_LDB(dst, b, h) do { _Pragma("unroll") for (int n = 0; n < 2; ++n) _Pragma("unroll") for (int k = 0; k < 2; ++k) dst[n][k] = *(const PG8_LAS bf16x8*)(lds + PG8_SB(b, h) + boff + n * 2048 + k * 1024); } while (0)
#define PG8_MMA(ai, bj, At, Bt) do { __builtin_amdgcn_s_setprio(1); _Pragma("unroll") for (int m = 0; m < 4; ++m) _Pragma("unroll") for (int n = 0; n < 2; ++n) _Pragma("unroll") for (int k = 0; k < 2; ++k) \
        acc[ai][bj][m][n] = __builtin_amdgcn_mfma_f32_16x16x32_bf16(Bt[n][k], At[m][k], acc[ai][bj][m][n], 0, 0, 0); __builtin_amdgcn_s_setprio(0); } while (0)
#define PG8_WAIT_V(n) asm volatile("s_waitcnt vmcnt(" #n ")" ::: "memory")
#define PG8_WAIT_L(n) asm volatile("s_waitcnt lgkmcnt(" #n ")" ::: "memory")
#define PG8_BAR __builtin_amdgcn_s_barrier()
#define PG8_SCHED __builtin_amdgcn_sched_barrier(0)
    Unit cur, nxt; int ui = 0;
    if (!S.next(0, cur)) return;
    f32x4 acc[2][2][4][2];
#pragma unroll
    for (int a = 0; a < 2; ++a)
#pragma unroll
        for (int b = 0; b < 2; ++b)
#pragma unroll
            for (int m = 0; m < 4; ++m)
#pragma unroll
                for (int n = 0; n < 2; ++n) acc[a][b][m][n] = (f32x4){0.f, 0.f, 0.f, 0.f};
    bf16x8 At[4][2], B0[2][2], B1[2][2];
    const char* cA = S.pa(g, cur, tstep); const char* cB = S.pb(g, cur, tstep);
    S.a_ready(cur);
    if constexpr (SP2) {
        PG8_STAGE(PG8_SB(0, 0), cB, voffB); PG8_STAGE(PG8_SB(0, 1), cB + hstep, voffB); PG8_STAGE(PG8_SA(0, 0), cA, voffA); PG8_STAGE(PG8_SA(0, 1), cA + hstep, voffA);
        if (wr == 1) PG8_BAR;
        PG8_WAIT_V(2); PG8_BAR;
        PG8_STAGE(PG8_SB(1, 0), cB + kstep, voffB); PG8_STAGE(PG8_SA(1, 0), cA + kstep, voffA); PG8_STAGE(PG8_SB(1, 1), cB + hstep + kstep, voffB);
        PG8_WAIT_V(6); PG8_BAR;
    } else {
        PG8_STAGE(PG8_SB(0, 0), cB, voffB); PG8_STAGE(PG8_SA(0, 0), cA, voffA); PG8_STAGE(PG8_SB(0, 1), cB + hstep, voffB); PG8_STAGE(PG8_SA(0, 1), cA + hstep, voffA);
        if (wr == 1) PG8_BAR;
        PG8_WAIT_V(4); PG8_BAR;
        PG8_STAGE(PG8_SB(1, 0), cB + kstep, voffB); PG8_STAGE(PG8_SA(1, 0), cA + kstep, voffA); PG8_STAGE(PG8_SB(1, 1), cB + hstep + kstep, voffB);
        PG8_WAIT_V(6); PG8_BAR;
    }
    for (;;) {
        const bool has_next = S.next(ui + 1, nxt);
        const char* nA = has_next ? S.pa(g, nxt, tstep) : cA; const char* nB = has_next ? S.pb(g, nxt, tstep) : cB;
        for (int t = 0; t < nt; t += 2) {
            const bool last = (t == nt - 2);
            const char* a1 = cA + (size_t)(t + 1) * kstep;
            const char* a2 = last ? nA : cA + (size_t)(t + 2) * kstep; const char* b2 = last ? nB : cB + (size_t)(t + 2) * kstep;
            const char* a3 = a2 + kstep; const char* b3 = b2 + kstep;
            if (last && has_next) S.a_ready(nxt);
            if constexpr (SP2) {
            PG8_LDB(B0, 0, 0); PG8_LDB(B1, 0, 1); PG8_SCHED; PG8_LDA(At, 0, 0); PG8_STAGE(PG8_SA(1, 1), a1 + hstep, voffA);
            PG8_WAIT_V(8); PG8_WAIT_L(0); PG8_BAR; PG8_MMA(0, 0, At, B0); PG8_MMA(0, 1, At, B1); PG8_BAR; PG8_SCHED;
            PG8_LDA(At, 0, 1); PG8_STAGE(PG8_SB(0, 0), b2, voffB); PG8_STAGE(PG8_SB(0, 1), b2 + hstep, voffB); PG8_STAGE(PG8_SA(0, 0), a2, voffA);
            PG8_WAIT_V(8); PG8_WAIT_L(0); PG8_BAR; PG8_MMA(1, 0, At, B0); PG8_MMA(1, 1, At, B1); PG8_BAR; PG8_SCHED;
            PG8_LDB(B0, 1, 0); PG8_LDB(B1, 1, 1); PG8_SCHED; PG8_LDA(At, 1, 0); PG8_STAGE(PG8_SA(0, 1), a2 + hstep, voffA);
            PG8_WAIT_V(8); PG8_WAIT_L(0); PG8_BAR; PG8_MMA(0, 0, At, B0); PG8_MMA(0, 1, At, B1); PG8_BAR; PG8_SCHED;
            PG8_LDA(At, 1, 1); PG8_STAGE(PG8_SB(1, 0), b3, voffB); PG8_STAGE(PG8_SB(1, 1), b3 + hstep, voffB); PG8_STAGE(PG8_SA(1, 0), a3, voffA);
            PG8_WAIT_V(8); PG8_WAIT_L(0); PG8_BAR; PG8_MMA(1, 0, At, B0); PG8_MMA(1, 1, At, B1); PG8_BAR; PG8_SCHED;
            } else {
            PG8_LDB(B0, 0, 0); PG8_SCHED; PG8_LDA(At, 0, 0); PG8_STAGE(PG8_SA(1, 1), a1 + hstep, voffA);
            PG8_WAIT_L(8); PG8_BAR; PG8_WAIT_L(0); PG8_MMA(0, 0, At, B0); PG8_BAR; PG8_SCHED;
            PG8_LDB(B1, 0, 1); PG8_STAGE(PG8_SB(0, 0), b2, voffB);
            PG8_BAR; PG8_WAIT_L(0); PG8_MMA(0, 1, At, B1); PG8_BAR;
            PG8_LDA(At, 0, 1); PG8_STAGE(PG8_SA(0, 0), a2, voffA);
            PG8_BAR; PG8_WAIT_L(0); PG8_MMA(1, 0, At, B0); PG8_BAR; PG8_SCHED;
            PG8_STAGE(PG8_SB(0, 1), b2 + hstep, voffB);
            PG8_WAIT_V(6); PG8_BAR; PG8_MMA(1, 1, At, B1); PG8_BAR;
            PG8_LDB(B0, 1, 0); PG8_SCHED; PG8_LDA(At, 1, 0); PG8_STAGE(PG8_SA(0, 1), a2 + hstep, voffA);
            PG8_WAIT_L(8); PG8_BAR; PG8_WAIT_L(0); PG8_MMA(0, 0, At, B0); PG8_BAR; PG8_SCHED;
            PG8_LDB(B1, 1, 1); PG8_STAGE(PG8_SB(1, 0), b3, voffB);
            PG8_BAR; PG8_WAIT_L(0); PG8_MMA(0, 1, At, B1); PG8_BAR;
            PG8_LDA(At, 1, 1); PG8_STAGE(PG8_SA(1, 0), a3, voffA);
            PG8_BAR; PG8_WAIT_L(0); PG8_MMA(1, 0, At, B0); PG8_BAR; PG8_SCHED;
            PG8_STAGE(PG8_SB(1, 1), b3 + hstep, voffB);
            PG8_WAIT_V(6); PG8_BAR; PG8_MMA(1, 1, At, B1); PG8_BAR;
            }
        }
        if constexpr (ALIGN_EPI) { if (wr == 0) PG8_BAR; }
        if constexpr (!Epi::AFTER_DRAIN) { E(acc, cur, wr, wc, fr, fq); S.done(cur); }
        if (!has_next) break;
#pragma unroll
        for (int a = 0; a < 2; ++a)
#pragma unroll
            for (int b = 0; b < 2; ++b)
#pragma unroll
                for (int m = 0; m < 4; ++m)
#pragma unroll
                    for (int n = 0; n < 2; ++n) acc[a][b][m][n] = (f32x4){0.f, 0.f, 0.f, 0.f};
        cur = nxt; cA = nA; cB = nB; ++ui;
        if constexpr (ALIGN_EPI) { if (wr == 1) PG8_BAR; }
    }
    PG8_WAIT_V(0);
    if constexpr (!ALIGN_EPI) { if (wr == 0) PG8_BAR; }
    PG8_BAR;
    if constexpr (Epi::AFTER_DRAIN) { E.fused(acc, cur, wr, wc, fr, fq, lds, wid, lane); S.done(cur); }
#undef PG8_SA
#undef PG8_SB
#undef PG8_STAGE
#undef PG8_LDA
#undef PG8_LDB
#undef PG8_MMA
#undef PG8_WAIT_V
#undef PG8_WAIT_L
#undef PG8_BAR
#undef PG8_SCHED
}
}

using pg8::bf16_t; using pg8::bf16x8; using pg8::f32x4; using pg8::u32x4; using pg8::cvt_pk_bf16; using pg8::Unit; using pg8::Gemm;
#define LAS __attribute__((address_space(3)))
typedef float f32x16 __attribute__((ext_vector_type(16)));
typedef unsigned u32x2 __attribute__((ext_vector_type(2)));
constexpr int SEQ = 16384, DM = 2048, DCONV = 1024, NH = 16, NKV = 4, HD = 64, DATT = 1024, DFF = 5632, FFH = 2816;
constexpr int DIN = 8704;
constexpr int C_BA = 0, C_CA = 1024, C_VA = 2048, C_Q = 3072, C_K = 4096, C_V = 4352, C_GA = 4608, C_GB = 6656;
constexpr float EPS = 1e-6f;
constexpr float LOG2E = 1.4426950408889634f;
constexpr float QSCALE = 0.125f * 1.4426950408889634f;
constexpr int NWAVES = 8, NTHREADS = 512;
constexpr int LDS_BYTES = 147456;

constexpr size_t MiB = (size_t)1 << 20;
constexpr size_t WS_SSQ2 = 0, WS_SSQ3 = 65536, WS_RSTD1 = 131072;
constexpr size_t WS_COS = 1 * MiB, WS_SIN = 3 * MiB;
constexpr size_t WS_WUP = 6 * MiB, WS_WDOWN = 50 * MiB;
constexpr size_t WS_Z = 72 * MiB;
constexpr size_t WS_H1B = 72 * MiB;
constexpr size_t WS_VT = 344 * MiB;
constexpr size_t WS_XB = 352 * MiB, WS_MB = 352 * MiB;
constexpr size_t WS_WIN = 416 * MiB, WS_BT3 = 450 * MiB, WS_WMIX = 458 * MiB;
constexpr size_t WS_EDGE = 136 * MiB;
constexpr size_t WS_ACT = 312 * MiB;
constexpr size_t WS_END = 488 * MiB;

__device__ __forceinline__ void unpack8(const u32x4 w, float (&f)[8]) {
    f[0] = __uint_as_float(w.x << 16); f[1] = __uint_as_float(w.x & 0xffff0000u);
    f[2] = __uint_as_float(w.y << 16); f[3] = __uint_as_float(w.y & 0xffff0000u);
    f[4] = __uint_as_float(w.z << 16); f[5] = __uint_as_float(w.z & 0xffff0000u);
    f[6] = __uint_as_float(w.w << 16); f[7] = __uint_as_float(w.w & 0xffff0000u);
}
__device__ __forceinline__ u32x4 pack8(const float (&f)[8]) {
    u32x4 w; w.x = cvt_pk_bf16(f[0], f[1]); w.y = cvt_pk_bf16(f[2], f[3]); w.z = cvt_pk_bf16(f[4], f[5]); w.w = cvt_pk_bf16(f[6], f[7]); return w;
}
__device__ __forceinline__ float sigmoidf_(float v) { return __builtin_amdgcn_rcpf(1.0f + __builtin_amdgcn_exp2f(-v * LOG2E)); }
__device__ __forceinline__ float wave_sum(float v) {
#pragma unroll
    for (int o = 1; o < 64; o <<= 1) v += __shfl_xor(v, o);
    return v;
}

struct Sched1 {
    pg8::StaticOrder so;
    __device__ void init(int G, int c) { so.init(SEQ, DIN, G, c); }
    __device__ bool next(int i, Unit& u) const { return so.next(i, u); }
    __device__ __forceinline__ const char* pa(const Gemm& g, const Unit& u, size_t tstep) const { return u.pn == 17 ? (const char*)g.Bt + (size_t)17 * tstep : (const char*)g.A + (size_t)u.pm * tstep; }
    __device__ __forceinline__ const char* pb(const Gemm& g, const Unit& u, size_t tstep) const { return u.pn == 17 ? (const char*)g.A + (size_t)u.pm * tstep : (const char*)g.Bt + (size_t)u.pn * tstep; }
    __device__ __forceinline__ void a_ready(const Unit&) const {}
    __device__ __forceinline__ void done(const Unit&) const {}
};
struct Sched3 {
    pg8::StaticOrder so;
    __device__ void init(int G, int c) { so.init(SEQ, DM, G, c); }
    __device__ bool next(int i, Unit& u) const { if (!so.next(i >> 1, u)) return false; if (i & 1) { u.pm += 64; u.pn += 8; } return true; }
    __device__ __forceinline__ const char* pa(const Gemm& g, const Unit& u, size_t tstep) const { return (const char*)g.A + (size_t)u.pm * tstep; }
    __device__ __forceinline__ const char* pb(const Gemm& g, const Unit& u, size_t tstep) const { return (const char*)g.Bt + (size_t)u.pn * tstep; }
    __device__ __forceinline__ void a_ready(const Unit&) const {}
    __device__ __forceinline__ void done(const Unit&) const {}
};

struct Epi1 {
    static constexpr bool PERM = true, PERMA = false, AFTER_DRAIN = false;
    bf16_t* z; bf16_t* vT; const float* rstd1; const float* cosT; const float* sinT; const float* bgate;
    __device__ __forceinline__ void operator()(const f32x4 (&acc)[2][2][4][2], const Unit& u, int wr, int wc, int fr, int fq) const {
        if (u.pn == 17) {
#pragma unroll
            for (int bj = 0; bj < 2; ++bj) {
                const int tok0 = u.pm * 256 + bj * 128 + wc * 32 + 8 * fq;
                const f32x4 r0 = *(const f32x4*)(rstd1 + tok0), r1 = *(const f32x4*)(rstd1 + tok0 + 4);
#pragma unroll
                for (int ai = 0; ai < 2; ++ai)
#pragma unroll
                    for (int m = 0; m < 4; ++m) {
                        const int d = ai * 128 + wr * 64 + m * 16 + fr;
                        const f32x4 v0 = acc[ai][bj][m][0] * r0, v1 = acc[ai][bj][m][1] * r1;
                        u32x4 w; w.x = cvt_pk_bf16(v0[0], v0[1]); w.y = cvt_pk_bf16(v0[2], v0[3]); w.z = cvt_pk_bf16(v1[0], v1[1]); w.w = cvt_pk_bf16(v1[2], v1[3]);
                        *(u32x4*)(vT + (size_t)d * SEQ + tok0) = w;
                    }
            }
            return;
        }
        const int kind = u.pn < 12 ? 0 : (u.pn < 17 ? 1 : 2);
#pragma unroll
        for (int ai = 0; ai < 2; ++ai)
#pragma unroll
            for (int m = 0; m < 4; ++m) {
                const int row = u.pm * 256 + ai * 128 + wr * 64 + m * 16 + fr;
                const float rs = rstd1[row];
                bf16_t* zr = z + (size_t)row * DIN;
#pragma unroll
                for (int bj = 0; bj < 2; ++bj) {
                    const int col0 = u.pn * 256 + bj * 128 + wc * 32 + 8 * fq;
                    f32x4 v0 = acc[ai][bj][m][0] * rs, v1 = acc[ai][bj][m][1] * rs;
                    if (kind == 1) {
                        const int hb = col0 & ~63, G4 = ((col0 & 63) >> 3) * 4;
                        const f32x4 cs = *(const f32x4*)(cosT + (size_t)row * 32 + G4), sn = *(const f32x4*)(sinT + (size_t)row * 32 + G4);
                        f32x4 o0 = v0 * cs - v1 * sn, o1 = v1 * cs + v0 * sn;
                        if (u.pn < 16) { o0 = o0 * QSCALE; o1 = o1 * QSCALE; }
                        u32x2 w0, w1; w0.x = cvt_pk_bf16(o0[0], o0[1]); w0.y = cvt_pk_bf16(o0[2], o0[3]); w1.x = cvt_pk_bf16(o1[0], o1[1]); w1.y = cvt_pk_bf16(o1[2], o1[3]);
                        *(u32x2*)(zr + hb + G4) = w0; *(u32x2*)(zr + hb + 32 + G4) = w1;
                    } else {
                        if (kind == 2) {
                            const f32x4 b0 = *(const f32x4*)(bgate + (col0 - C_GA)), b1 = *(const f32x4*)(bgate + (col0 - C_GA) + 4);
                            v0 = v0 + b0; v1 = v1 + b1;
#pragma unroll
                            for (int j = 0; j < 4; ++j) { v0[j] = sigmoidf_(v0[j]); v1[j] = sigmoidf_(v1[j]); }
                        }
                        u32x4 w; w.x = cvt_pk_bf16(v0[0], v0[1]); w.y = cvt_pk_bf16(v0[2], v0[3]); w.z = cvt_pk_bf16(v1[0], v1[1]); w.w = cvt_pk_bf16(v1[2], v1[3]);
                        *(u32x4*)(zr + col0) = w;
                    }
                }
            }
    }
};
struct Epi3 {
    static constexpr bool PERM = true, PERMA = false, AFTER_DRAIN = false;
    const bf16_t* z; bf16_t* P; bf16_t* mb;
    __device__ __forceinline__ void operator()(const f32x4 (&acc)[2][2][4][2], const Unit& u, int wr, int wc, int fr, int fq) const {
        const bool second = u.pm >= 64; const int pm = u.pm & 63, pn = u.pn & 7;
#pragma unroll
        for (int ai = 0; ai < 2; ++ai)
#pragma unroll
            for (int m = 0; m < 4; ++m) {
                const int row = pm * 256 + ai * 128 + wr * 64 + m * 16 + fr;
#pragma unroll
                for (int bj = 0; bj < 2; ++bj) {
                    const int col0 = pn * 256 + bj * 128 + wc * 32 + 8 * fq;
                    float g[8]; unpack8(*(const u32x4*)(z + (size_t)row * DIN + (second ? C_GB : C_GA) + col0), g);
                    float v[8];
#pragma unroll
                    for (int j = 0; j < 4; ++j) { v[j] = acc[ai][bj][m][0][j] * g[j]; v[4 + j] = acc[ai][bj][m][1][j] * g[4 + j]; }
                    if (second) {
                        float p[8]; unpack8(*(const u32x4*)(P + (size_t)row * DM + col0), p);
#pragma unroll
                        for (int j = 0; j < 8; ++j) v[j] += p[j];
                        *(u32x4*)(mb + (size_t)row * DM + col0) = pack8(v);
                    } else {
                        *(u32x4*)(P + (size_t)row * DM + col0) = pack8(v);
                    }
                }
            }
    }
};
struct EpiRes {
    static constexpr bool PERM = true, PERMA = false, AFTER_DRAIN = false;
    const float* hin; float* hout; bf16_t* hb; float* ssq;
    __device__ __forceinline__ void operator()(const f32x4 (&acc)[2][2][4][2], const Unit& u, int wr, int wc, int fr, int fq) const {
#pragma unroll
        for (int ai = 0; ai < 2; ++ai)
#pragma unroll
            for (int m = 0; m < 4; ++m) {
                const int row = u.pm * 256 + ai * 128 + wr * 64 + m * 16 + fr;
                float ss = 0.f;
#pragma unroll
                for (int bj = 0; bj < 2; ++bj) {
                    const int col0 = u.pn * 256 + bj * 128 + wc * 32 + 8 * fq;
                    const size_t off = (size_t)row * DM + col0;
                    const f32x4 h0 = *(const f32x4*)(hin + off) + acc[ai][bj][m][0], h1 = *(const f32x4*)(hin + off + 4) + acc[ai][bj][m][1];
                    *(f32x4*)(hout + off) = h0; *(f32x4*)(hout + off + 4) = h1;
                    ss += (h0[0] * h0[0] + h0[1] * h0[1]) + (h0[2] * h0[2] + h0[3] * h0[3]) + (h1[0] * h1[0] + h1[1] * h1[1]) + (h1[2] * h1[2] + h1[3] * h1[3]);
                    if (hb) { u32x4 w; w.x = cvt_pk_bf16(h0[0], h0[1]); w.y = cvt_pk_bf16(h0[2], h0[3]); w.z = cvt_pk_bf16(h1[0], h1[1]); w.w = cvt_pk_bf16(h1[2], h1[3]); *(u32x4*)(hb + off) = w; }
                }
                ss += __shfl_xor(ss, 16); ss += __shfl_xor(ss, 32);
                if (fq == 0) unsafeAtomicAdd(ssq + row, ss);
            }
    }
};
struct Epi5F {
    static constexpr bool PERM = true, PERMA = true, AFTER_DRAIN = false;
    bf16_t* act; bf16_t* edge; const float* ssq2; const float* cw; const float* cb;
    __device__ __forceinline__ void operator()(const f32x4 (&acc)[2][2][4][2], const Unit& u, int wr, int wc, int fr, int fq) const {
        const int ch0 = u.pn * 128 + wc * 32 + 8 * fq;
#pragma unroll
        for (int ai = 0; ai < 2; ++ai) {
            const int rbase = u.pm * 256 + ai * 128 + wr * 64, slab = rbase >> 6;
            const f32x4 sq = *(const f32x4*)(ssq2 + rbase + 4 * fr);
            float rs[4];
#pragma unroll
            for (int m = 0; m < 4; ++m) rs[m] = 1.0f / sqrtf(sq[m] * (1.0f / DM) + EPS);
            f32x4 V[2][4][2];
#pragma unroll
            for (int bj = 0; bj < 2; ++bj)
#pragma unroll
                for (int m = 0; m < 4; ++m)
#pragma unroll
                    for (int n = 0; n < 2; ++n) V[bj][m][n] = acc[ai][bj][m][n] * rs[m];
            if (fr == 0 || fr == 15) {
                const int e0 = fr == 0 ? 0 : 2;
#pragma unroll
                for (int e = 0; e < 2; ++e)
#pragma unroll
                    for (int bj = 0; bj < 2; ++bj) {
                        const f32x4 v0 = fr == 0 ? V[bj][e][0] : V[bj][2 + e][0], v1 = fr == 0 ? V[bj][e][1] : V[bj][2 + e][1];
                        u32x4 w; w.x = cvt_pk_bf16(v0[0], v0[1]); w.y = cvt_pk_bf16(v0[2], v0[3]); w.z = cvt_pk_bf16(v1[0], v1[1]); w.w = cvt_pk_bf16(v1[2], v1[3]);
                        *(u32x4*)(edge + ((size_t)((slab * 4 + e0 + e) * 2 + bj)) * DFF + ch0) = w;
                    }
            }
            u32x2 PK[4][2];
#pragma unroll
            for (int n = 0; n < 2; ++n) {
                f32x4 O[2][4];
#pragma unroll
                for (int bj = 0; bj < 2; ++bj) {
                    f32x4 pv, nx;
#pragma unroll
                    for (int j = 0; j < 4; ++j) { pv[j] = __shfl_up(V[bj][3][n][j], 1, 16); nx[j] = __shfl_down(V[bj][0][n][j], 1, 16); }
                    const int pc = bj * DFF + ch0 + 4 * n;
                    const f32x4 w0 = *(const f32x4*)(cw + pc), w1 = *(const f32x4*)(cw + 2 * DFF + pc), w2 = *(const f32x4*)(cw + 4 * DFF + pc), bb = *(const f32x4*)(cb + pc);
                    O[bj][0] = w0 * pv + w1 * V[bj][0][n] + w2 * V[bj][1][n] + bb;
                    O[bj][1] = w0 * V[bj][0][n] + w1 * V[bj][1][n] + w2 * V[bj][2][n] + bb;
                    O[bj][2] = w0 * V[bj][1][n] + w1 * V[bj][2][n] + w2 * V[bj][3][n] + bb;
                    O[bj][3] = w0 * V[bj][2][n] + w1 * V[bj][3][n] + w2 * nx + bb;
                }
#pragma unroll
                for (int m = 0; m < 4; ++m) {
                    float r[4];
#pragma unroll
                    for (int j = 0; j < 4; ++j) { const float A = O[0][m][j]; r[j] = A * sigmoidf_(A) * O[1][m][j]; }
                    PK[m][n].x = cvt_pk_bf16(r[0], r[1]); PK[m][n].y = cvt_pk_bf16(r[2], r[3]);
                }
            }
#pragma unroll
            for (int m = 0; m < 4; ++m) {
                u32x4 w; w.x = PK[m][0].x; w.y = PK[m][0].y; w.z = PK[m][1].x; w.w = PK[m][1].y;
                *(u32x4*)(act + (size_t)(rbase + 4 * fr + m) * DFF + ch0) = w;
            }
        }
    }
};

enum { RM_ID = 0, RM_WIN = 1, RM_UP = 2 };
template <int RM> __device__ __forceinline__ int rowmap(int n) {
    if (RM == RM_WIN) { if (n >= C_Q && n < C_V) { const int base = n & ~63, d = n & 63; return base + 8 * ((d & 31) >> 2) + 4 * (d >> 5) + (d & 3); } return n; }
    if (RM == RM_UP) { const int isgv = n >= DFF ? 1 : 0; const int cc = n - DFF * isgv; return 256 * (cc >> 7) + 128 * isgv + (cc & 127); }
    return n;
}
template <int RM> __device__ __forceinline__ void p0_transpose_item(const float* W, const float* gk, int K, int N, bf16_t* WT, int row_off, LAS float* scr, int item, int lane) {
    const int nblk = N / 64, kb = item / nblk, nb = item - kb * nblk, k0 = 64 * kb, n0 = 64 * nb;
    const int r = lane >> 4, n4 = (lane & 15) * 4;
    f32x4 v[16];
#pragma unroll
    for (int i = 0; i < 16; ++i) v[i] = *(const f32x4*)(W + (size_t)(k0 + 4 * i + r) * N + n0 + n4);
#pragma unroll
    for (int i = 0; i < 16; ++i) {
        const int kk = 4 * i + r; f32x4 w = v[i]; if (gk) w = w * gk[k0 + kk];
        LAS float* d = scr + kk * 65 + n4; d[0] = w[0]; d[1] = w[1]; d[2] = w[2]; d[3] = w[3];
    }
    asm volatile("s_waitcnt lgkmcnt(0)" ::: "memory");
    const int c = lane & 7;
#pragma unroll
    for (int j = 0; j < 8; ++j) { const int n = (lane >> 3) + 8 * j; const LAS float* s = scr + (8 * c) * 65 + n;
        u32x4 o; o.x = cvt_pk_bf16(s[0 * 65], s[1 * 65]); o.y = cvt_pk_bf16(s[2 * 65], s[3 * 65]); o.z = cvt_pk_bf16(s[4 * 65], s[5 * 65]); o.w = cvt_pk_bf16(s[6 * 65], s[7 * 65]);
        *(u32x4*)(WT + (size_t)(row_off + rowmap<RM>(n0 + n)) * K + k0 + 8 * c) = o; }
    asm volatile("s_waitcnt lgkmcnt(0)" ::: "memory");
}

struct Args { const float* in[15]; float* out; unsigned char* ws; int ph_lo, ph_hi; };

__device__ __forceinline__ void phase_prologue(const Args& a, LAS unsigned char* lds, int tid, int lane, int wave, int vcu, int G) {
    unsigned char* ws = a.ws;
    LAS float* scr = (LAS float*)(lds + wave * 16640);
    const int gw = vcu * NWAVES + wave, NGW = G * NWAVES;
    constexpr int I_IN = (DM / 64) * (DIN / 64), I_OA = (DCONV / 64) * (DM / 64), I_OB = (DATT / 64) * (DM / 64), I_MIX = (DM / 64) * (DM / 64), I_UP = (DM / 64) * (2 * DFF / 64), I_DN = (DFF / 64) * (DM / 64);
    constexpr int NITEMS = I_IN + I_OA + I_OB + I_MIX + I_UP + I_DN;
    for (int it = gw; it < NITEMS; it += NGW) {
        int r = it;
        if (r < I_IN) { p0_transpose_item<RM_WIN>(a.in[2], a.in[1], DM, DIN, (bf16_t*)(ws + WS_WIN), 0, scr, r, lane); continue; } r -= I_IN;
        if (r < I_OA) { p0_transpose_item<RM_ID>(a.in[5], nullptr, DCONV, DM, (bf16_t*)(ws + WS_BT3), 0, scr, r, lane); continue; } r -= I_OA;
        if (r < I_OB) { p0_transpose_item<RM_ID>(a.in[7], nullptr, DATT, DM, (bf16_t*)(ws + WS_BT3), DM, scr, r, lane); continue; } r -= I_OB;
        if (r < I_MIX) { p0_transpose_item<RM_ID>(a.in[8], nullptr, DM, DM, (bf16_t*)(ws + WS_WMIX), 0, scr, r, lane); continue; } r -= I_MIX;
        if (r < I_UP) { p0_transpose_item<RM_UP>(a.in[10], a.in[9], DM, 2 * DFF, (bf16_t*)(ws + WS_WUP), 0, scr, r, lane); continue; } r -= I_UP;
        p0_transpose_item<RM_ID>(a.in[13], nullptr, DFF, DM, (bf16_t*)(ws + WS_WDOWN), 0, scr, r, lane);
    }
    const float* x = a.in[0]; bf16_t* xb = (bf16_t*)(ws + WS_XB); float* rstd1 = (float*)(ws + WS_RSTD1);
    for (int m = gw; m < SEQ; m += NGW) {
        const f32x4* xr = (const f32x4*)(x + (size_t)m * DM) + lane; f32x4 v[8]; float s = 0.f;
#pragma unroll
        for (int j = 0; j < 8; ++j) { v[j] = xr[64 * j]; s += (v[j][0] * v[j][0] + v[j][1] * v[j][1]) + (v[j][2] * v[j][2] + v[j][3] * v[j][3]); }
        s = wave_sum(s);
        u32x2* o8 = (u32x2*)(xb + (size_t)m * DM) + lane;
#pragma unroll
        for (int j = 0; j < 8; ++j) { u32x2 w; w.x = cvt_pk_bf16(v[j][0], v[j][1]); w.y = cvt_pk_bf16(v[j][2], v[j][3]); o8[64 * j] = w; }
        if (lane == 0) rstd1[m] = 1.0f / sqrtf(s * (1.0f / DM) + EPS);
    }
    const int gt = vcu * NTHREADS + tid, NGT = G * NTHREADS;
    float* cosT = (float*)(ws + WS_COS); float* sinT = (float*)(ws + WS_SIN);
    for (int idx = gt; idx < SEQ * 32; idx += NGT) {
        const int t = idx >> 5, i = idx & 31;
        double f = 1.0; for (int k = 0; k < i; ++k) f *= 0.7498942093324559;
        const float inv = (float)f; const float angf = (float)t * inv;
        const double ang = (double)angf;
        const double kq = __builtin_rint(ang * 0.6366197723675814);
        double y = __builtin_fma(-kq, 1.5707963267948966, ang); y = __builtin_fma(-kq, 6.123233995736766e-17, y);
        const double y2 = y * y;
        double sp = -1.0 / 1307674368000.0; sp = sp * y2 + 1.0 / 6227020800.0; sp = sp * y2 - 1.0 / 39916800.0; sp = sp * y2 + 1.0 / 362880.0; sp = sp * y2 - 1.0 / 5040.0; sp = sp * y2 + 1.0 / 120.0; sp = sp * y2 - 1.0 / 6.0; sp = sp * y2 + 1.0; sp = sp * y;
        double cp = 1.0 / 20922789888000.0; cp = cp * y2 - 1.0 / 87178291200.0; cp = cp * y2 + 1.0 / 479001600.0; cp = cp * y2 - 1.0 / 3628800.0; cp = cp * y2 + 1.0 / 40320.0; cp = cp * y2 - 1.0 / 720.0; cp = cp * y2 + 1.0 / 24.0; cp = cp * y2 - 0.5; cp = cp * y2 + 1.0;
        const int q = ((int)kq) & 3;
        const double sv = (q == 0) ? sp : (q == 1) ? cp : (q == 2) ? -sp : -cp;
        const double cv = (q == 0) ? cp : (q == 1) ? -sp : (q == 2) ? -cp : sp;
        cosT[idx] = (float)cv; sinT[idx] = (float)sv;
    }
    float* ssq2 = (float*)(ws + WS_SSQ2); float* ssq3 = (float*)(ws + WS_SSQ3);
    for (int idx = gt; idx < SEQ; idx += NGT) { ssq2[idx] = 0.f; ssq3[idx] = 0.f; }
}

__device__ __forceinline__ void load_cv(const bf16_t* z, int t, int c0, float (&cv)[8]) {
    if (t < 0 || t >= SEQ) {
#pragma unroll
        for (int j = 0; j < 8; ++j) cv[j] = 0.f;
        return;
    }
    float c[8], v[8]; unpack8(*(const u32x4*)(z + (size_t)t * DIN + C_CA + c0), c); unpack8(*(const u32x4*)(z + (size_t)t * DIN + C_VA + c0), v);
#pragma unroll
    for (int j = 0; j < 8; ++j) cv[j] = c[j] * v[j];
}
__device__ __forceinline__ void phase_mixer(const Args& a, int lane, int gw, int NGW) {
    const bf16_t* z = (const bf16_t*)(a.ws + WS_Z); bf16_t* ya = (bf16_t*)a.out; const float* cw = a.in[4];
    for (int it = gw; it < (SEQ / 16) * 2; it += NGW) {
        const int t0 = (it >> 1) * 16, c0 = (it & 1) * 512 + 8 * lane;
        float w0[8], w1[8], w2[8];
#pragma unroll
        for (int j = 0; j < 8; ++j) { w0[j] = cw[c0 + j]; w1[j] = cw[DCONV + c0 + j]; w2[j] = cw[2 * DCONV + c0 + j]; }
        float prev[8], cur[8], nxt[8];
        load_cv(z, t0 - 1, c0, prev); load_cv(z, t0, c0, cur);
        for (int t = t0; t < t0 + 16; ++t) {
            load_cv(z, t + 1, c0, nxt);
            float b[8]; unpack8(*(const u32x4*)(z + (size_t)t * DIN + C_BA + c0), b);
            float o[8];
#pragma unroll
            for (int j = 0; j < 8; ++j) { o[j] = b[j] * (w0[j] * prev[j] + w1[j] * cur[j] + w2[j] * nxt[j]); prev[j] = cur[j]; cur[j] = nxt[j]; }
            *(u32x4*)(ya + (size_t)t * DCONV + c0) = pack8(o);
        }
    }
}

constexpr int KROW = 144, VROW = 656, KWIN = 320, LDS_KB = KWIN * KROW;
__device__ __forceinline__ void attn_unit(LAS unsigned char* lds, const bf16_t* z, const bf16_t* vT, bf16_t* att, const float* sink, int kh, int qb, int tid) {
    asm volatile("" : "+v"(tid));
    const int lane = tid & 63, wid = __builtin_amdgcn_readfirstlane(tid >> 6), l31 = lane & 31, hi = lane >> 5;
    const int q0 = qb * 64;
#pragma unroll
    for (int i = 0; i < 5; ++i) {
        const int id = tid + 512 * i, r = id >> 3, ch = id & 7, t = q0 - 128 + r;
        u32x4 v = (u32x4){0u, 0u, 0u, 0u};
        if (t >= 0 && t < SEQ) v = *(const u32x4*)(z + (size_t)t * DIN + C_K + 64 * kh + 8 * ch);
        *(LAS u32x4*)(lds + r * KROW + ch * 16) = v;
    }
#pragma unroll
    for (int i = 0; i < 5; ++i) {
        const int id = tid + 512 * i, d = id / 40, ch = id - d * 40, t = q0 - 128 + 8 * ch;
        u32x4 v = (u32x4){0u, 0u, 0u, 0u};
        if (t >= 0 && t < SEQ) v = *(const u32x4*)(vT + (size_t)(64 * kh + d) * SEQ + t);
        *(LAS u32x4*)(lds + LDS_KB + d * VROW + ch * 16) = v;
    }
    __syncthreads();
    const int g = wid >> 1, sb = wid & 1, head = 4 * kh + g, q0w = q0 + 32 * sb;
    bf16x8 qr[4];
#pragma unroll
    for (int ds = 0; ds < 4; ++ds) qr[ds] = *(const bf16x8*)(z + (size_t)(q0w + l31) * DIN + C_Q + head * 64 + 16 * ds + 8 * hi);
    const int pi = (l31 & 0x13) | ((l31 & 4) << 1) | ((l31 & 8) >> 1);
    f32x16 s[9];
#pragma unroll
    for (int tl = 0; tl < 9; ++tl) {
        const LAS unsigned char* kp = lds + (32 * (sb + tl) + pi) * KROW + 16 * hi;
        f32x16 acc = (f32x16){0.f, 0.f, 0.f, 0.f, 0.f, 0.f, 0.f, 0.f, 0.f, 0.f, 0.f, 0.f, 0.f, 0.f, 0.f, 0.f};
#pragma unroll
        for (int ds = 0; ds < 4; ++ds) { const bf16x8 kf = *(const LAS bf16x8*)(kp + 32 * ds); acc = __builtin_amdgcn_mfma_f32_32x32x16_bf16(kf, qr[ds], acc, 0, 0, 0); }
        s[tl] = acc;
    }
    const float sinkl = sink[head] * LOG2E;
    float mx = sinkl;
    const int qpos = q0w + l31;
#pragma unroll
    for (int tl = 0; tl < 9; ++tl)
#pragma unroll
        for (int r = 0; r < 16; ++r) {
            const int kpos = q0w - 128 + 32 * tl + 16 * (r >> 3) + 8 * hi + (r & 7);
            const int dlt = kpos - qpos;
            const bool ok = (dlt >= -128) && (dlt <= 128) && (kpos >= 0) && (kpos < SEQ);
            const float v = ok ? s[tl][r] : -INFINITY;
            s[tl][r] = v; mx = fmaxf(mx, v);
        }
    mx = fmaxf(mx, __shfl_xor(mx, 32));
    float sum = 0.f;
#pragma unroll
    for (int tl = 0; tl < 9; ++tl)
#pragma unroll
        for (int r = 0; r < 16; ++r) { const float p = __builtin_amdgcn_exp2f(s[tl][r] - mx); s[tl][r] = p; sum += p; }
    sum += __shfl_xor(sum, 32);
    const float inv = 1.0f / (sum + __builtin_amdgcn_exp2f(sinkl - mx));
    f32x16 o[2];
    o[0] = (f32x16){0.f, 0.f, 0.f, 0.f, 0.f, 0.f, 0.f, 0.f, 0.f, 0.f, 0.f, 0.f, 0.f, 0.f, 0.f, 0.f}; o[1] = o[0];
#pragma unroll
    for (int tl = 0; tl < 9; ++tl)
#pragma unroll
        for (int s2 = 0; s2 < 2; ++s2) {
            u32x4 pw; pw.x = cvt_pk_bf16(s[tl][8 * s2 + 0], s[tl][8 * s2 + 1]); pw.y = cvt_pk_bf16(s[tl][8 * s2 + 2], s[tl][8 * s2 + 3]);
            pw.z = cvt_pk_bf16(s[tl][8 * s2 + 4], s[tl][8 * s2 + 5]); pw.w = cvt_pk_bf16(s[tl][8 * s2 + 6], s[tl][8 * s2 + 7]);
            const bf16x8 pb = __builtin_bit_cast(bf16x8, pw);
#pragma unroll
            for (int db = 0; db < 2; ++db) {
                const bf16x8 vf = *(const LAS bf16x8*)(lds + LDS_KB + (32 * db + l31) * VROW + (32 * (sb + tl) + 16 * s2 + 8 * hi) * 2);
                o[db] = __builtin_amdgcn_mfma_f32_32x32x16_bf16(vf, pb, o[db], 0, 0, 0);
            }
        }
    bf16_t* orow = att + (size_t)(q0w + l31) * DATT + head * 64;
#pragma unroll
    for (int db = 0; db < 2; ++db)
#pragma unroll
        for (int rg = 0; rg < 4; ++rg) {
            u32x2 w; w.x = cvt_pk_bf16(o[db][4 * rg + 0] * inv, o[db][4 * rg + 1] * inv); w.y = cvt_pk_bf16(o[db][4 * rg + 2] * inv, o[db][4 * rg + 3] * inv);
            *(u32x2*)(orow + 32 * db + 8 * rg + 4 * hi) = w;
        }
    __syncthreads();
}

__device__ __forceinline__ void load_edge(const bf16_t* edge, int slab, int e, int bj, int ch, float (&f)[8]) {
    if (slab < 0 || slab >= SEQ / 64) {
#pragma unroll
        for (int j = 0; j < 8; ++j) f[j] = 0.f;
        return;
    }
    unpack8(*(const u32x4*)(edge + ((size_t)((slab * 4 + e) * 2 + bj)) * DFF + ch), f);
}
__device__ __forceinline__ void phase_fixup(const Args& a, int gt, int NGT) {
    const bf16_t* edge = (const bf16_t*)(a.ws + WS_EDGE); bf16_t* act = (bf16_t*)(a.ws + WS_ACT); const float* cw = a.in[11]; const float* cb = a.in[12];
    for (int idx = gt; idx < (SEQ / 64) * 2 * (DFF / 8); idx += NGT) {
        const int rowi = idx / (DFF / 8), chunk = idx - rowi * (DFF / 8), slab = rowi >> 1, last = rowi & 1, ch = 8 * chunk;
        const int row = 64 * slab + (last ? 63 : 0);
        float o[2][8];
#pragma unroll
        for (int bj = 0; bj < 2; ++bj) {
            float p[8], c[8], n[8];
            if (last) { load_edge(edge, slab, 2, bj, ch, p); load_edge(edge, slab, 3, bj, ch, c); load_edge(edge, slab + 1, 0, bj, ch, n); }
            else      { load_edge(edge, slab - 1, 3, bj, ch, p); load_edge(edge, slab, 0, bj, ch, c); load_edge(edge, slab, 1, bj, ch, n); }
            const int pc = bj * DFF + ch;
#pragma unroll
            for (int j = 0; j < 8; ++j) o[bj][j] = cw[pc + j] * p[j] + cw[2 * DFF + pc + j] * c[j] + cw[4 * DFF + pc + j] * n[j] + cb[pc + j];
        }
        float r[8];
#pragma unroll
        for (int j = 0; j < 8; ++j) r[j] = o[0][j] * sigmoidf_(o[0][j]) * o[1][j];
        *(u32x4*)(act + (size_t)row * DFF + ch) = pack8(r);
    }
}

constexpr size_t WS_BAR = 196608 + 256;
__device__ __forceinline__ void grid_barrier(unsigned* cnt, unsigned target) {
    asm volatile("s_waitcnt vmcnt(0)" ::: "memory");
    __syncthreads();
    if (threadIdx.x == 0) {
        __builtin_amdgcn_fence(__ATOMIC_RELEASE, "agent");
        asm volatile("s_waitcnt vmcnt(0)" ::: "memory");
        __hip_atomic_fetch_add(cnt, 1u, __ATOMIC_RELAXED, __HIP_MEMORY_SCOPE_AGENT);
        while (__hip_atomic_load(cnt, __ATOMIC_RELAXED, __HIP_MEMORY_SCOPE_AGENT) < target) __builtin_amdgcn_s_sleep(2);
        __builtin_amdgcn_fence(__ATOMIC_ACQUIRE, "agent");
        asm volatile("s_waitcnt vmcnt(0)" ::: "memory");
    }
    __syncthreads();
}

__global__ void __launch_bounds__(NTHREADS, 2) fwd_megakernel(Args args) {
    extern __shared__ __attribute__((aligned(16))) unsigned char lds_raw[];
    LAS unsigned char* lds = (LAS unsigned char*)lds_raw;
    const int tid = threadIdx.x, lane = tid & 63, wave = __builtin_amdgcn_readfirstlane(tid >> 6);
    const int G = gridDim.x, bx = blockIdx.x;
    const int vcu = (G % 8 == 0) ? (bx % 8) * (G / 8) + bx / 8 : bx;
    const int gw = vcu * NWAVES + wave, NGW = G * NWAVES;
    unsigned char* ws = args.ws;
    const int lo = args.ph_lo, hi = args.ph_hi;
#define IN(k) (lo <= (k) && (k) < hi)
    unsigned* barw = (unsigned*)(ws + WS_BAR); unsigned nbar = 0;
#define SEAM(k) do { if (IN(k) && IN((k) + 1)) { nbar += (unsigned)G; grid_barrier(barw, nbar); } } while (0)

    if (IN(0)) {
        if (bx == 0 && tid == 0) __hip_atomic_store(barw, 0u, __ATOMIC_RELAXED, __HIP_MEMORY_SCOPE_AGENT);
        phase_prologue(args, lds, tid, lane, wave, vcu, G);
#ifdef PROBE_DUP_P0
        __syncthreads(); phase_prologue(args, lds, tid, lane, wave, vcu, G);
#endif
    }
    if (IN(0) && IN(1)) { cg::this_grid().sync(); }
    if (IN(1)) {
        Gemm g{(const bf16_t*)(ws + WS_XB), (const bf16_t*)(ws + WS_WIN), SEQ, DIN, DM}; Sched1 S; S.init(G, bx);
        Epi1 E{(bf16_t*)(ws + WS_Z), (bf16_t*)(ws + WS_VT), (const float*)(ws + WS_RSTD1), (const float*)(ws + WS_COS), (const float*)(ws + WS_SIN), args.in[3]};
        pg8::gemm_phase<Epi1, Sched1, true, true>(lds, g, S, E);
    }
    SEAM(1);
    if (IN(2)) {
        phase_mixer(args, lane, gw, NGW);
        const bf16_t* z = (const bf16_t*)(ws + WS_Z); const bf16_t* vT = (const bf16_t*)(ws + WS_VT); bf16_t* att = (bf16_t*)args.out + (size_t)SEQ * DCONV;
        for (int u = vcu; u < NKV * (SEQ / 64); u += G) attn_unit(lds, z, vT, att, args.in[6], u & 3, u >> 2, tid);
#ifdef PROBE_DUP_ATT
        for (int u = vcu; u < NKV * (SEQ / 64); u += G) attn_unit(lds, z, vT, att, args.in[6], u & 3, u >> 2, tid);
#endif
#ifdef PROBE_DUP_MIX
        phase_mixer(args, lane, gw, NGW);
#endif
    }
    SEAM(2);
    if (IN(3)) {
        Gemm g{(const bf16_t*)args.out, (const bf16_t*)(ws + WS_BT3), 2 * SEQ, 2 * DM, DCONV}; Sched3 S; S.init(G, bx);
        Epi3 E{(const bf16_t*)(ws + WS_Z), (bf16_t*)args.out + (size_t)2 * SEQ * DCONV, (bf16_t*)(ws + WS_MB)};
        pg8::gemm_phase<Epi3, Sched3, true, true>(lds, g, S, E);
    }
    SEAM(3);
    if (IN(4)) {
        Gemm g{(const bf16_t*)(ws + WS_MB), (const bf16_t*)(ws + WS_WMIX), SEQ, DM, DM}; pg8::StaticOrder S; S.init(SEQ, DM, G, bx);
        EpiRes E{args.in[0], args.out, (bf16_t*)(ws + WS_H1B), (float*)(ws + WS_SSQ2)};
        pg8::gemm_phase<EpiRes, pg8::StaticOrder, true, true>(lds, g, S, E);
    }
    SEAM(4);
    if (IN(5)) {
        Gemm g{(const bf16_t*)(ws + WS_H1B), (const bf16_t*)(ws + WS_WUP), SEQ, 2 * DFF, DM}; pg8::StaticOrder S; S.init(SEQ, 2 * DFF, G, bx);
        Epi5F E{(bf16_t*)(ws + WS_ACT), (bf16_t*)(ws + WS_EDGE), (const float*)(ws + WS_SSQ2), args.in[11], args.in[12]};
        pg8::gemm_phase<Epi5F, pg8::StaticOrder, true, true>(lds, g, S, E);
    }
    SEAM(5);
    if (IN(6)) { phase_fixup(args, vcu * NTHREADS + tid, G * NTHREADS); }
    SEAM(6);
    if (IN(7)) {
        Gemm g{(const bf16_t*)(ws + WS_ACT), (const bf16_t*)(ws + WS_WDOWN), SEQ, DM, DFF}; pg8::StaticOrder S; S.init(SEQ, DM, G, bx);
        EpiRes E{args.out, args.out, nullptr, (float*)(ws + WS_SSQ3)};
        pg8::gemm_phase<EpiRes, pg8::StaticOrder, true, true>(lds, g, S, E);
    }
    SEAM(7);
#ifdef PROBE_BARS
    for (int rep = 0; rep < 10; ++rep) { nbar += (unsigned)G; grid_barrier(barw, nbar); }
#endif
    if (IN(8)) {
        const float* ssq3 = (const float*)(ws + WS_SSQ3); const float* gf = args.in[14];
        for (int m = gw; m < SEQ; m += NGW) {
            const float rs = 1.0f / sqrtf(ssq3[m] * (1.0f / DM) + EPS);
            f32x4* xr = (f32x4*)(args.out + (size_t)m * DM) + lane; const f32x4* gr = (const f32x4*)gf + lane;
#pragma unroll
            for (int j = 0; j < 8; ++j) { const f32x4 v = xr[64 * j] * rs * gr[64 * j]; xr[64 * j] = v; }
        }
    }
#undef IN
#undef SEAM
}

constexpr int N_PHASES = 9;
extern "C" void kernel_launch(void* const* d_in, const int* in_sizes, int n_in, void* d_out, int out_size, void* d_ws, size_t ws_size, hipStream_t stream) {
    static int grid = 0;
    if (grid == 0) {
        if (n_in != 15 || in_sizes[0] != SEQ * DM || out_size != SEQ * DM || ws_size < WS_END) { fprintf(stderr, "kernel_launch: unexpected shapes / workspace (n_in %d, in0 %d, out %d, ws %zu)\n", n_in, n_in > 0 ? in_sizes[0] : -1, out_size, ws_size); grid = -1; return; }
        int dev = 0, cus = 0;
        if (hipGetDevice(&dev) != hipSuccess || hipDeviceGetAttribute(&cus, hipDeviceAttributeMultiprocessorCount, dev) != hipSuccess) { grid = -1; return; }
        if (hipFuncSetAttribute((const void*)fwd_megakernel, hipFuncAttributeMaxDynamicSharedMemorySize, LDS_BYTES) != hipSuccess) { fprintf(stderr, "kernel_launch: hipFuncSetAttribute failed\n"); grid = -1; return; }
        int per_cu = 0;
        if (hipOccupancyMaxActiveBlocksPerMultiprocessor(&per_cu, (const void*)fwd_megakernel, NTHREADS, LDS_BYTES) != hipSuccess || per_cu < 1) { fprintf(stderr, "kernel_launch: occupancy query says %d blocks per CU\n", per_cu); (void)hipGetLastError(); }
        grid = cus;
    }
    if (grid < 0) return;
    Args a{};
    for (int i = 0; i < 15; ++i) a.in[i] = (const float*)d_in[i];
    a.out = (float*)d_out; a.ws = (unsigned char*)d_ws;
#if MK_N_LAUNCHES == 1
    a.ph_lo = 0; a.ph_hi = N_PHASES;
    void* kargs[] = {&a};
    hipError_t e = hipLaunchCooperativeKernel((const void*)fwd_megakernel, dim3(grid), dim3(NTHREADS), kargs, LDS_BYTES, stream);
    if (e != hipSuccess) fprintf(stderr, "kernel_launch: cooperative launch failed: %s (grid %d)\n", hipGetErrorString(e), grid);
#else
    for (int ph = 0; ph < N_PHASES; ++ph) {
        a.ph_lo = ph; a.ph_hi = ph + 1;
        hipLaunchKernelGGL(fwd_megakernel, dim3(grid), dim3(NTHREADS), LDS_BYTES, stream, a);
    }
#endif
}
```

```cpp
#include <hip/hip_runtime.h>
#include <hip/hip_cooperative_groups.h>
#include <cstdio>
#include <cstdint>
namespace cg = cooperative_groups;
#ifndef MK_N_LAUNCHES
#define MK_N_LAUNCHES 1
#endif

namespace pg8 {
#define PG8_LAS __attribute__((address_space(3)))
typedef unsigned short bf16_t;
typedef short bf16x8 __attribute__((ext_vector_type(8)));
typedef float f32x4 __attribute__((ext_vector_type(4)));
typedef unsigned u32x4 __attribute__((ext_vector_type(4)));
constexpr int BM = 256, BK = 64, HALF = 128, HTB = HALF * BK * 2  , STAGE_BYTES = 8 * HTB, NXCD = 8, WGM = 8;

__host__ __device__ __forceinline__ int lds_byte(int r, int c) { const int st = (r >> 4) * 2 + (c >> 5), rr = r & 15, cc = c & 31, ob = rr * 64 + cc * 2; return st * 1024 + (ob ^ (((ob >> 9) & 1) << 5)); }
__host__ __device__ __forceinline__ void stage_rc(int b, int& R, int& C) { const int st = b / 1024, sb = b % 1024, swz = sb ^ (((sb >> 9) & 1) << 5); R = (st >> 1) * 16 + swz / 64; C = (st & 1) * 32 + (swz % 64) / 2; }
__host__ __device__ __forceinline__ int perm32(int rho) { const int n = rho >> 4, i = rho & 15; return 8 * (i >> 2) + 4 * n + (i & 3); }

struct Unit { int pm, pn; };
struct Gemm { const bf16_t* A; const bf16_t* Bt; int M, N, K; };

struct StaticOrder {
    int nM, nN, nwg, G, c;
    __host__ __device__ void init(int M, int N, int G_, int c_) { nM = M / BM; nN = N / BM; nwg = nM * nN; G = G_; c = c_; }
    __host__ __device__ bool next(int i, Unit& u) const {
        const long L = (long)i * G + c; if (L >= nwg) return false;
        int wgid = (int)L; { const int q = nwg / NXCD, r = nwg % NXCD, xcd = wgid % NXCD, off = wgid / NXCD; wgid = (xcd < r ? xcd * (q + 1) : r * (q + 1) + (xcd - r) * q) + off; }
        const int nig = WGM * nN, gid = wgid / nig, fm = gid * WGM, gsz = (nM - fm) < WGM ? (nM - fm) : WGM;
        u.pm = fm + ((wgid % nig) % gsz); u.pn = (wgid % nig) / gsz; return true;
    }
    __device__ __forceinline__ const char* pa(const Gemm& g, const Unit& u, size_t tstep) const { return (const char*)g.A + (size_t)u.pm * tstep; }
    __device__ __forceinline__ const char* pb(const Gemm& g, const Unit& u, size_t tstep) const { return (const char*)g.Bt + (size_t)u.pn * tstep; }
    __device__ __forceinline__ void a_ready(const Unit&) const {}
    __device__ __forceinline__ void done(const Unit&) const {}
};

__device__ __forceinline__ unsigned cvt_pk_bf16(float lo, float hi) { unsigned r; asm volatile("v_cvt_pk_bf16_f32 %0, %1, %2" : "=v"(r) : "v"(lo), "v"(hi)); return r; }
typedef float f32x2 __attribute__((ext_vector_type(2)));
template <class Epi, class Sched, bool ALIGN_EPI = false, bool SP2 = false>
__device__ __forceinline__ void gemm_phase(PG8_LAS unsigned char* lds, const Gemm g, const Sched& S, const Epi& E) {
    const int tid = threadIdx.x, wid = __builtin_amdgcn_readfirstlane(tid >> 6), lane = tid & 63, wr = wid >> 2, wc = wid & 3, fr = lane & 15, fq = lane >> 4;
    const int K = g.K, nt = K / BK;
    unsigned voffA[2], voffB[2];
#pragma unroll
    for (int i = 0; i < 2; ++i) { int R, C; stage_rc(tid * 16 + i * 8192, R, C); const int Rb = Epi::PERM ? ((R & ~31) + perm32(R & 31)) : R;
        const int Ra = Epi::PERMA ? ((R & ~63) + 4 * (R & 15) + ((R >> 4) & 3)) : R;
        voffA[i] = (unsigned)(Ra * K + C) * 2u; voffB[i] = (unsigned)(Rb * K + C) * 2u; }
    const size_t kstep = (size_t)(BK * 2);
    const size_t hstep = (size_t)HALF * K * 2;
    const size_t tstep = 2 * hstep;
    const unsigned ldsw = (unsigned)wid * 1024u;
    const int aoff = lds_byte(wr * 64 + fr, fq * 8), boff = lds_byte(wc * 32 + fr, fq * 8);
#define PG8_SA(b, h) (((b) * 2 + (h)) * HTB)
#define PG8_SB(b, h) ((4 + (b) * 2 + (h)) * HTB)
#define PG8_STAGE(bufoff, gbase, voff) do { _Pragma("unroll") for (int _i = 0; _i < 2; ++_i) \
        __builtin_amdgcn_global_load_lds((const unsigned*)((const char*)(gbase) + (voff)[_i]), (PG8_LAS unsigned*)(lds + (bufoff) + ldsw + _i * 8192), 16, 0, 0); } while (0)
#define PG8_LDA(dst, b, h) do { _Pragma("unroll") for (int m = 0; m < 4; ++m) _Pragma("unroll") for (int k = 0; k < 2; ++k) dst[m][k] = *(const PG8_LAS bf16x8*)(lds + PG8_SA(b, h) + aoff + m * 2048 + k * 1024); } while (0)
#define PG8_LDB(dst, b, h) do { _Pragma("unroll") for (int n = 0; n < 2; ++n) _Pragma("unroll") for (int k = 0; k < 2; ++k) dst[n][k] = *(const PG8_LAS bf16x8*)(lds + PG8_SB(b, h) + boff + n * 2048 + k * 1024); } while (0)
#define PG8_MMA(ai, bj, At, Bt) do { __builtin_amdgcn_s_setprio(1); _Pragma("unroll") for (int m = 0; m < 4; ++m) _Pragma("unroll") for (int n = 0; n < 2; ++n) _Pragma("unroll") for (int k = 0; k < 2; ++k) \
        acc[ai][bj][m][n] = __builtin_amdgcn_mfma_f32_16x16x32_bf16(Bt[n][k], At[m][k], acc[ai][bj][m][n], 0, 0, 0); __builtin_amdgcn_s_setprio(0); } while (0)
#define PG8_WAIT_V(n) asm volatile("s_waitcnt vmcnt(" #n ")" ::: "memory")
#define PG8_WAIT_L(n) asm volatile("s_waitcnt lgkmcnt(" #n ")" ::: "memory")
#define PG8_BAR __builtin_amdgcn_s_barrier()
#define PG8_SCHED __builtin_amdgcn_sched_barrier(0)
    Unit cur, nxt; int ui = 0;
    if (!S.next(0, cur)) return;
    f32x4 acc[2][2][4][2];
#pragma unroll
    for (int a = 0; a < 2; ++a)
#pragma unroll
        for (int b = 0; b < 2; ++b)
#pragma unroll
            for (int m = 0; m < 4; ++m)
#pragma unroll
                for (int n = 0; n < 2; ++n) acc[a][b][m][n] = (f32x4){0.f, 0.f, 0.f, 0.f};
    bf16x8 At[4][2], B0[2][2], B1[2][2];
    const char* cA = S.pa(g, cur, tstep); const char* cB = S.pb(g, cur, tstep);
    S.a_ready(cur);
    if constexpr (SP2) {
        PG8_STAGE(PG8_SB(0, 0), cB, voffB); PG8_STAGE(PG8_SB(0, 1), cB + hstep, voffB); PG8_STAGE(PG8_SA(0, 0), cA, voffA); PG8_STAGE(PG8_SA(0, 1), cA + hstep, voffA);
        if (wr == 1) PG8_BAR;
        PG8_WAIT_V(2); PG8_BAR;
        PG8_STAGE(PG8_SB(1, 0), cB + kstep, voffB); PG8_STAGE(PG8_SA(1, 0), cA + kstep, voffA); PG8_STAGE(PG8_SB(1, 1), cB + hstep + kstep, voffB);
        PG8_WAIT_V(6); PG8_BAR;
    } else {
        PG8_STAGE(PG8_SB(0, 0), cB, voffB); PG8_STAGE(PG8_SA(0, 0), cA, voffA); PG8_STAGE(PG8_SB(0, 1), cB + hstep, voffB); PG8_STAGE(PG8_SA(0, 1), cA + hstep, voffA);
        if (wr == 1) PG8_BAR;
        PG8_WAIT_V(4); PG8_BAR;
        PG8_STAGE(PG8_SB(1, 0), cB + kstep, voffB); PG8_STAGE(PG8_SA(1, 0), cA + kstep, voffA); PG8_STAGE(PG8_SB(1, 1), cB + hstep + kstep, voffB);
        PG8_WAIT_V(6); PG8_BAR;
    }
    for (;;) {
        const bool has_next = S.next(ui + 1, nxt);
        const char* nA = has_next ? S.pa(g, nxt, tstep) : cA; const char* nB = has_next ? S.pb(g, nxt, tstep) : cB;
        for (int t = 0; t < nt; t += 2) {
            const bool last = (t == nt - 2);
            const char* a1 = cA + (size_t)(t + 1) * kstep;
            const char* a2 = last ? nA : cA + (size_t)(t + 2) * kstep; const char* b2 = last ? nB : cB + (size_t)(t + 2) * kstep;
            const char* a3 = a2 + kstep; const char* b3 = b2 + kstep;
            if (last && has_next) S.a_ready(nxt);
            if constexpr (SP2) {
            PG8_LDB(B0, 0, 0); PG8_LDB(B1, 0, 1); PG8_SCHED; PG8_LDA(At, 0, 0); PG8_STAGE(PG8_SA(1, 1), a1 + hstep, voffA);
            PG8_WAIT_V(8); PG8_WAIT_L(0); PG8_BAR; PG8_MMA(0, 0, At, B0); PG8_MMA(0, 1, At, B1); PG8_BAR; PG8_SCHED;
            PG8_LDA(At, 0, 1); PG8_STAGE(PG8_SB(0, 0), b2, voffB); PG8_STAGE(PG8_SB(0, 1), b2 + hstep, voffB); PG8_STAGE(PG8_SA(0, 0), a2, voffA);
            PG8_WAIT_V(8); PG8_WAIT_L(0); PG8_BAR; PG8_MMA(1, 0, At, B0); PG8_MMA(1, 1, At, B1); PG8_BAR; PG8_SCHED;
            PG8_LDB(B0, 1, 0); PG8_LDB(B1, 1, 1); PG8_SCHED; PG8_LDA(At, 1, 0); PG8_STAGE(PG8_SA(0, 1), a2 + hstep, voffA);
            PG8_WAIT_V(8); PG8_WAIT_L(0); PG8_BAR; PG8_MMA(0, 0, At, B0); PG8_MMA(0, 1, At, B1); PG8_BAR; PG8_SCHED;
            PG8_LDA(At, 1, 1); PG8_STAGE(PG8_SB(1, 0), b3, voffB); PG8_STAGE(PG8_SB(1, 1), b3 + hstep, voffB); PG8_STAGE(PG8_SA(1, 0), a3, voffA);
            PG8_WAIT_V(8); PG8_WAIT_L(0); PG8_BAR; PG8_MMA(1, 0, At, B0); PG8_MMA(1, 1, At, B1); PG8_BAR; PG8_SCHED;
            } else {
            PG8_LDB(B0, 0, 0); PG8_SCHED; PG8_LDA(At, 0, 0); PG8_STAGE(PG8_SA(1, 1), a1 + hstep, voffA);
            PG8_WAIT_L(8); PG8_BAR; PG8_WAIT_L(0); PG8_MMA(0, 0, At, B0); PG8_BAR; PG8_SCHED;
            PG8_LDB(B1, 0, 1); PG8_STAGE(PG8_SB(0, 0), b2, voffB);
            PG8_BAR; PG8_WAIT_L(0); PG8_MMA(0, 1, At, B1); PG8_BAR;
            PG8_LDA(At, 0, 1); PG8_STAGE(PG8_SA(0, 0), a2, voffA);
            PG8_BAR; PG8_WAIT_L(0); PG8_MMA(1, 0, At, B0); PG8_BAR; PG8_SCHED;
            PG8_STAGE(PG8_SB(0, 1), b2 + hstep, voffB);
            PG8_WAIT_V(6); PG8_BAR; PG8_MMA(1, 1, At, B1); PG8_BAR;
            PG8_LDB(B0, 1, 0); PG8_SCHED; PG8_LDA(At, 1, 0); PG8_STAGE(PG8_SA(0, 1), a2 + hstep, voffA);
            PG8_WAIT_L(8); PG8_BAR; PG8_WAIT_L(0); PG8_MMA(0, 0, At, B0); PG8_BAR; PG8_SCHED;
            PG8_LDB(B1, 1, 1); PG8_STAGE(PG8_SB(1, 0), b3, voffB);
            PG8_BAR; PG8_WAIT_L(0); PG8_MMA(0, 1, At, B1); PG8_BAR;
            PG8_LDA(At, 1, 1); PG8_STAGE(PG8_SA(1, 0), a3, voffA);
            PG8_BAR; PG8_WAIT_L(0); PG8_MMA(1, 0, At, B0); PG8_BAR; PG8_SCHED;
            PG8_STAGE(PG8_SB(1, 1), b3 + hstep, voffB);
            PG8_WAIT_V(6); PG8_BAR; PG8_MMA(1, 1, At, B1); PG8_BAR;
            }
        }
        if constexpr (ALIGN_EPI) { if (wr == 0) PG8_BAR; }
        if constexpr (!Epi::AFTER_DRAIN) { E(acc, cur, wr, wc, fr, fq); S.done(cur); }
        if (!has_next) break;
#pragma unroll
        for (int a = 0; a < 2; ++a)
#pragma unroll
            for (int b = 0; b < 2; ++b)
#pragma unroll
                for (int m = 0; m < 4; ++m)
#pragma unroll
                    for (int n = 0; n < 2; ++n) acc[a][b][m][n] = (f32x4){0.f, 0.f, 0.f, 0.f};
        cur = nxt; cA = nA; cB = nB; ++ui;
        if constexpr (ALIGN_EPI) { if (wr == 1) PG8_BAR; }
    }
    PG8_WAIT_V(0);
    if constexpr (!ALIGN_EPI) { if (wr == 0) PG8_BAR; }
    PG8_BAR;
    if constexpr (Epi::AFTER_DRAIN) { E.fused(acc, cur, wr, wc, fr, fq, lds, wid, lane); S.done(cur); }
#undef PG8_SA
#undef PG8_SB
#undef PG8_STAGE
#undef PG8_LDA
#undef PG8_LDB
#undef PG8_MMA
#undef PG8_WAIT_V
#undef PG8_WAIT_L
#undef PG8_BAR
#undef PG8_SCHED
}
}

using pg8::bf16_t; using pg8::bf16x8; using pg8::f32x4; using pg8::u32x4; using pg8::cvt_pk_bf16; using pg8::Unit; using pg8::Gemm;
#define LAS __attribute__((address_space(3)))
typedef float f32x16 __attribute__((ext_vector_type(16)));
typedef unsigned u32x2 __attribute__((ext_vector_type(2)));
constexpr int SEQ = 16384, DM = 2048, DCONV = 1024, NH = 16, NKV = 4, HD = 64, DATT = 1024, DFF = 5632, FFH = 2816;
constexpr int DIN = 8704;
constexpr int C_BA = 0, C_CA = 1024, C_VA = 2048, C_Q = 3072, C_K = 4096, C_V = 4352, C_GA = 4608, C_GB = 6656;
constexpr float EPS = 1e-6f;
constexpr float LOG2E = 1.4426950408889634f;
constexpr float QSCALE = 0.125f * 1.4426950408889634f;
constexpr int NWAVES = 8, NTHREADS = 512;
constexpr int LDS_BYTES = 147456;

constexpr size_t MiB = (size_t)1 << 20;
constexpr size_t WS_SSQ2 = 0, WS_SSQ3 = 65536, WS_RSTD1 = 131072;
constexpr size_t WS_COS = 1 * MiB, WS_SIN = 3 * MiB;
constexpr size_t WS_WUP = 6 * MiB, WS_WDOWN = 50 * MiB;
constexpr size_t WS_Z = 72 * MiB;
constexpr size_t WS_H1B = 72 * MiB;
constexpr size_t WS_VT = 344 * MiB;
constexpr size_t WS_XB = 352 * MiB, WS_MB = 352 * MiB;
constexpr size_t WS_WIN = 416 * MiB, WS_BT3 = 450 * MiB, WS_WMIX = 458 * MiB;
constexpr size_t WS_EDGE = 136 * MiB;
constexpr size_t WS_ACT = 312 * MiB;
constexpr size_t WS_END = 488 * MiB;

__device__ __forceinline__ void unpack8(const u32x4 w, float (&f)[8]) {
    f[0] = __uint_as_float(w.x << 16); f[1] = __uint_as_float(w.x & 0xffff0000u);
    f[2] = __uint_as_float(w.y << 16); f[3] = __uint_as_float(w.y & 0xffff0000u);
    f[4] = __uint_as_float(w.z << 16); f[5] = __uint_as_float(w.z & 0xffff0000u);
    f[6] = __uint_as_float(w.w << 16); f[7] = __uint_as_float(w.w & 0xffff0000u);
}
__device__ __forceinline__ u32x4 pack8(const float (&f)[8]) {
    u32x4 w; w.x = cvt_pk_bf16(f[0], f[1]); w.y = cvt_pk_bf16(f[2], f[3]); w.z = cvt_pk_bf16(f[4], f[5]); w.w = cvt_pk_bf16(f[6], f[7]); return w;
}
__device__ __forceinline__ float sigmoidf_(float v) { return __builtin_amdgcn_rcpf(1.0f + __builtin_amdgcn_exp2f(-v * LOG2E)); }
__device__ __forceinline__ float wave_sum(float v) {
#pragma unroll
    for (int o = 1; o < 64; o <<= 1) v += __shfl_xor(v, o);
    return v;
}

struct Sched1 {
    pg8::StaticOrder so;
    __device__ void init(int G, int c) { so.init(SEQ, DIN, G, c); }
    __device__ bool next(int i, Unit& u) const { return so.next(i, u); }
    __device__ __forceinline__ const char* pa(const Gemm& g, const Unit& u, size_t tstep) const { return u.pn == 17 ? (const char*)g.Bt + (size_t)17 * tstep : (const char*)g.A + (size_t)u.pm * tstep; }
    __device__ __forceinline__ const char* pb(const Gemm& g, const Unit& u, size_t tstep) const { return u.pn == 17 ? (const char*)g.A + (size_t)u.pm * tstep : (const char*)g.Bt + (size_t)u.pn * tstep; }
    __device__ __forceinline__ void a_ready(const Unit&) const {}
    __device__ __forceinline__ void done(const Unit&) const {}
};
struct Sched3 {
    pg8::StaticOrder so;
    __device__ void init(int G, int c) { so.init(SEQ, DM, G, c); }
    __device__ bool next(int i, Unit& u) const { if (!so.next(i >> 1, u)) return false; if (i & 1) { u.pm += 64; u.pn += 8; } return true; }
    __device__ __forceinline__ const char* pa(const Gemm& g, const Unit& u, size_t tstep) const { return (const char*)g.A + (size_t)u.pm * tstep; }
    __device__ __forceinline__ const char* pb(const Gemm& g, const Unit& u, size_t tstep) const { return (const char*)g.Bt + (size_t)u.pn * tstep; }
    __device__ __forceinline__ void a_ready(const Unit&) const {}
    __device__ __forceinline__ void done(const Unit&) const {}
};

struct Epi1 {
    static constexpr bool PERM = true, PERMA = false, AFTER_DRAIN = false;
    bf16_t* z; bf16_t* vT; const float* rstd1; const float* cosT; const float* sinT; const float* bgate;
    __device__ __forceinline__ void operator()(const f32x4 (&acc)[2][2][4][2], const Unit& u, int wr, int wc, int fr, int fq) const {
        if (u.pn == 17) {
#pragma unroll
            for (int bj = 0; bj < 2; ++bj) {
                const int tok0 = u.pm * 256 + bj * 128 + wc * 32 + 8 * fq;
                const f32x4 r0 = *(const f32x4*)(rstd1 + tok0), r1 = *(const f32x4*)(rstd1 + tok0 + 4);
#pragma unroll
                for (int ai = 0; ai < 2; ++ai)
#pragma unroll
                    for (int m = 0; m < 4; ++m) {
                        const int d = ai * 128 + wr * 64 + m * 16 + fr;
                        const f32x4 v0 = acc[ai][bj][m][0] * r0, v1 = acc[ai][bj][m][1] * r1;
                        u32x4 w; w.x = cvt_pk_bf16(v0[0], v0[1]); w.y = cvt_pk_bf16(v0[2], v0[3]); w.z = cvt_pk_bf16(v1[0], v1[1]); w.w = cvt_pk_bf16(v1[2], v1[3]);
                        *(u32x4*)(vT + (size_t)d * SEQ + tok0) = w;
                    }
            }
            return;
        }
        const int kind = u.pn < 12 ? 0 : (u.pn < 17 ? 1 : 2);
#pragma unroll
        for (int ai = 0; ai < 2; ++ai)
#pragma unroll
            for (int m = 0; m < 4; ++m) {
                const int row = u.pm * 256 + ai * 128 + wr * 64 + m * 16 + fr;
                const float rs = rstd1[row];
                bf16_t* zr = z + (size_t)row * DIN;
#pragma unroll
                for (int bj = 0; bj < 2; ++bj) {
                    const int col0 = u.pn * 256 + bj * 128 + wc * 32 + 8 * fq;
                    f32x4 v0 = acc[ai][bj][m][0] * rs, v1 = acc[ai][bj][m][1] * rs;
                    if (kind == 1) {
                        const int hb = col0 & ~63, G4 = ((col0 & 63) >> 3) * 4;
                        const f32x4 cs = *(const f32x4*)(cosT + (size_t)row * 32 + G4), sn = *(const f32x4*)(sinT + (size_t)row * 32 + G4);
                        f32x4 o0 = v0 * cs - v1 * sn, o1 = v1 * cs + v0 * sn;
                        if (u.pn < 16) { o0 = o0 * QSCALE; o1 = o1 * QSCALE; }
                        u32x2 w0, w1; w0.x = cvt_pk_bf16(o0[0], o0[1]); w0.y = cvt_pk_bf16(o0[2], o0[3]); w1.x = cvt_pk_bf16(o1[0], o1[1]); w1.y = cvt_pk_bf16(o1[2], o1[3]);
                        *(u32x2*)(zr + hb + G4) = w0; *(u32x2*)(zr + hb + 32 + G4) = w1;
                    } else {
                        if (kind == 2) {
                            const f32x4 b0 = *(const f32x4*)(bgate + (col0 - C_GA)), b1 = *(const f32x4*)(bgate + (col0 - C_GA) + 4);
                            v0 = v0 + b0; v1 = v1 + b1;
#pragma unroll
                            for (int j = 0; j < 4; ++j) { v0[j] = sigmoidf_(v0[j]); v1[j] = sigmoidf_(v1[j]); }
                        }
                        u32x4 w; w.x = cvt_pk_bf16(v0[0], v0[1]); w.y = cvt_pk_bf16(v0[2], v0[3]); w.z = cvt_pk_bf16(v1[0], v1[1]); w.w = cvt_pk_bf16(v1[2], v1[3]);
                        *(u32x4*)(zr + col0) = w;
                    }
                }
            }
    }
};
struct Epi3 {
    static constexpr bool PERM = true, PERMA = false, AFTER_DRAIN = false;
    const bf16_t* z; bf16_t* P; bf16_t* mb;
    __device__ __forceinline__ void operator()(const f32x4 (&acc)[2][2][4][2], const Unit& u, int wr, int wc, int fr, int fq) const {
        const bool second = u.pm >= 64; const int pm = u.pm & 63, pn = u.pn & 7;
#pragma unroll
        for (int ai = 0; ai < 2; ++ai)
#pragma unroll
            for (int m = 0; m < 4; ++m) {
                const int row = pm * 256 + ai * 128 + wr * 64 + m * 16 + fr;
#pragma unroll
                for (int bj = 0; bj < 2; ++bj) {
                    const int col0 = pn * 256 + bj * 128 + wc * 32 + 8 * fq;
                    float g[8]; unpack8(*(const u32x4*)(z + (size_t)row * DIN + (second ? C_GB : C_GA) + col0), g);
                    float v[8];
#pragma unroll
                    for (int j = 0; j < 4; ++j) { v[j] = acc[ai][bj][m][0][j] * g[j]; v[4 + j] = acc[ai][bj][m][1][j] * g[4 + j]; }
                    if (second) {
                        float p[8]; unpack8(*(const u32x4*)(P + (size_t)row * DM + col0), p);
#pragma unroll
                        for (int j = 0; j < 8; ++j) v[j] += p[j];
                        *(u32x4*)(mb + (size_t)row * DM + col0) = pack8(v);
                    } else {
                        *(u32x4*)(P + (size_t)row * DM + col0) = pack8(v);
                    }
                }
            }
    }
};
struct EpiRes {
    static constexpr bool PERM = true, PERMA = false, AFTER_DRAIN = false;
    const float* hin; float* hout; bf16_t* hb; float* ssq;
    __device__ __forceinline__ void operator()(const f32x4 (&acc)[2][2][4][2], const Unit& u, int wr, int wc, int fr, int fq) const {
#pragma unroll
        for (int ai = 0; ai < 2; ++ai)
#pragma unroll
            for (int m = 0; m < 4; ++m) {
                const int row = u.pm * 256 + ai * 128 + wr * 64 + m * 16 + fr;
                float ss = 0.f;
#pragma unroll
                for (int bj = 0; bj < 2; ++bj) {
                    const int col0 = u.pn * 256 + bj * 128 + wc * 32 + 8 * fq;
                    const size_t off = (size_t)row * DM + col0;
                    const f32x4 h0 = *(const f32x4*)(hin + off) + acc[ai][bj][m][0], h1 = *(const f32x4*)(hin + off + 4) + acc[ai][bj][m][1];
                    *(f32x4*)(hout + off) = h0; *(f32x4*)(hout + off + 4) = h1;
                    ss += (h0[0] * h0[0] + h0[1] * h0[1]) + (h0[2] * h0[2] + h0[3] * h0[3]) + (h1[0] * h1[0] + h1[1] * h1[1]) + (h1[2] * h1[2] + h1[3] * h1[3]);
                    if (hb) { u32x4 w; w.x = cvt_pk_bf16(h0[0], h0[1]); w.y = cvt_pk_bf16(h0[2], h0[3]); w.z = cvt_pk_bf16(h1[0], h1[1]); w.w = cvt_pk_bf16(h1[2], h1[3]); *(u32x4*)(hb + off) = w; }
                }
                ss += __shfl_xor(ss, 16); ss += __shfl_xor(ss, 32);
                if (fq == 0) unsafeAtomicAdd(ssq + row, ss);
            }
    }
};
struct Epi5F {
    static constexpr bool PERM = true, PERMA = true, AFTER_DRAIN = false;
    bf16_t* act; bf16_t* edge; const float* ssq2; const float* cw; const float* cb;
    __device__ __forceinline__ void operator()(const f32x4 (&acc)[2][2][4][2], const Unit& u, int wr, int wc, int fr, int fq) const {
        const int ch0 = u.pn * 128 + wc * 32 + 8 * fq;
#pragma unroll
        for (int ai = 0; ai < 2; ++ai) {
            const int rbase = u.pm * 256 + ai * 128 + wr * 64, slab = rbase >> 6;
            const f32x4 sq = *(const f32x4*)(ssq2 + rbase + 4 * fr);
            float rs[4];
#pragma unroll
            for (int m = 0; m < 4; ++m) rs[m] = 1.0f / sqrtf(sq[m] * (1.0f / DM) + EPS);
            f32x4 V[2][4][2];
#pragma unroll
            for (int bj = 0; bj < 2; ++bj)
#pragma unroll
                for (int m = 0; m < 4; ++m)
#pragma unroll
                    for (int n = 0; n < 2; ++n) V[bj][m][n] = acc[ai][bj][m][n] * rs[m];
            if (fr == 0 || fr == 15) {
                const int e0 = fr == 0 ? 0 : 2;
#pragma unroll
                for (int e = 0; e < 2; ++e)
#pragma unroll
                    for (int bj = 0; bj < 2; ++bj) {
                        const f32x4 v0 = fr == 0 ? V[bj][e][0] : V[bj][2 + e][0], v1 = fr == 0 ? V[bj][e][1] : V[bj][2 + e][1];
                        u32x4 w; w.x = cvt_pk_bf16(v0[0], v0[1]); w.y = cvt_pk_bf16(v0[2], v0[3]); w.z = cvt_pk_bf16(v1[0], v1[1]); w.w = cvt_pk_bf16(v1[2], v1[3]);
                        *(u32x4*)(edge + ((size_t)((slab * 4 + e0 + e) * 2 + bj)) * DFF + ch0) = w;
                    }
            }
            u32x2 PK[4][2];
#pragma unroll
            for (int n = 0; n < 2; ++n) {
                f32x4 O[2][4];
#pragma unroll
                for (int bj = 0; bj < 2; ++bj) {
                    f32x4 pv, nx;
#pragma unroll
                    for (int j = 0; j < 4; ++j) { pv[j] = __shfl_up(V[bj][3][n][j], 1, 16); nx[j] = __shfl_down(V[bj][0][n][j], 1, 16); }
                    const int pc = bj * DFF + ch0 + 4 * n;
                    const f32x4 w0 = *(const f32x4*)(cw + pc), w1 = *(const f32x4*)(cw + 2 * DFF + pc), w2 = *(const f32x4*)(cw + 4 * DFF + pc), bb = *(const f32x4*)(cb + pc);
                    O[bj][0] = w0 * pv + w1 * V[bj][0][n] + w2 * V[bj][1][n] + bb;
                    O[bj][1] = w0 * V[bj][0][n] + w1 * V[bj][1][n] + w2 * V[bj][2][n] + bb;
                    O[bj][2] = w0 * V[bj][1][n] + w1 * V[bj][2][n] + w2 * V[bj][3][n] + bb;
                    O[bj][3] = w0 * V[bj][2][n] + w1 * V[bj][3][n] + w2 * nx + bb;
                }
#pragma unroll
                for (int m = 0; m < 4; ++m) {
                    float r[4];
#pragma unroll
                    for (int j = 0; j < 4; ++j) { const float A = O[0][m][j]; r[j] = A * sigmoidf_(A) * O[1][m][j]; }
                    PK[m][n].x = cvt_pk_bf16(r[0], r[1]); PK[m][n].y = cvt_pk_bf16(r[2], r[3]);
                }
            }
#pragma unroll
            for (int m = 0; m < 4; ++m) {
                u32x4 w; w.x = PK[m][0].x; w.y = PK[m][0].y; w.z = PK[m][1].x; w.w = PK[m][1].y;
                *(u32x4*)(act + (size_t)(rbase + 4 * fr + m) * DFF + ch0) = w;
            }
        }
    }
};

enum { RM_ID = 0, RM_WIN = 1, RM_UP = 2 };
template <int RM> __device__ __forceinline__ int rowmap(int n) {
    if (RM == RM_WIN) { if (n >= C_Q && n < C_V) { const int base = n & ~63, d = n & 63; return base + 8 * ((d & 31) >> 2) + 4 * (d >> 5) + (d & 3); } return n; }
    if (RM == RM_UP) { const int isgv = n >= DFF ? 1 : 0; const int cc = n - DFF * isgv; return 256 * (cc >> 7) + 128 * isgv + (cc & 127); }
    return n;
}
template <int RM> __device__ __forceinline__ void p0_transpose_item(const float* W, const float* gk, int K, int N, bf16_t* WT, int row_off, LAS float* scr, int item, int lane) {
    const int nblk = N / 64, kb = item / nblk, nb = item - kb * nblk, k0 = 64 * kb, n0 = 64 * nb;
    const int r = lane >> 4, n4 = (lane & 15) * 4;
    f32x4 v[16];
#pragma unroll
    for (int i = 0; i < 16; ++i) v[i] = *(const f32x4*)(W + (size_t)(k0 + 4 * i + r) * N + n0 + n4);
#pragma unroll
    for (int i = 0; i < 16; ++i) {
        const int kk = 4 * i + r; f32x4 w = v[i]; if (gk) w = w * gk[k0 + kk];
        LAS float* d = scr + kk * 65 + n4; d[0] = w[0]; d[1] = w[1]; d[2] = w[2]; d[3] = w[3];
    }
    asm volatile("s_waitcnt lgkmcnt(0)" ::: "memory");
    const int c = lane & 7;
#pragma unroll
    for (int j = 0; j < 8; ++j) { const int n = (lane >> 3) + 8 * j; const LAS float* s = scr + (8 * c) * 65 + n;
        u32x4 o; o.x = cvt_pk_bf16(s[0 * 65], s[1 * 65]); o.y = cvt_pk_bf16(s[2 * 65], s[3 * 65]); o.z = cvt_pk_bf16(s[4 * 65], s[5 * 65]); o.w = cvt_pk_bf16(s[6 * 65], s[7 * 65]);
        *(u32x4*)(WT + (size_t)(row_off + rowmap<RM>(n0 + n)) * K + k0 + 8 * c) = o; }
    asm volatile("s_waitcnt lgkmcnt(0)" ::: "memory");
}

struct Args { const float* in[15]; float* out; unsigned char* ws; int ph_lo, ph_hi; };

__device__ __forceinline__ void phase_prologue(const Args& a, LAS unsigned char* lds, int tid, int lane, int wave, int vcu, int G) {
    unsigned char* ws = a.ws;
    LAS float* scr = (LAS float*)(lds + wave * 16640);
    const int gw = vcu * NWAVES + wave, NGW = G * NWAVES;
    constexpr int I_IN = (DM / 64) * (DIN / 64), I_OA = (DCONV / 64) * (DM / 64), I_OB = (DATT / 64) * (DM / 64), I_MIX = (DM / 64) * (DM / 64), I_UP = (DM / 64) * (2 * DFF / 64), I_DN = (DFF / 64) * (DM / 64);
    constexpr int NITEMS = I_IN + I_OA + I_OB + I_MIX + I_UP + I_DN;
    for (int it = gw; it < NITEMS; it += NGW) {
        int r = it;
        if (r < I_IN) { p0_transpose_item<RM_WIN>(a.in[2], a.in[1], DM, DIN, (bf16_t*)(ws + WS_WIN), 0, scr, r, lane); continue; } r -= I_IN;
        if (r < I_OA) { p0_transpose_item<RM_ID>(a.in[5], nullptr, DCONV, DM, (bf16_t*)(ws + WS_BT3), 0, scr, r, lane); continue; } r -= I_OA;
        if (r < I_OB) { p0_transpose_item<RM_ID>(a.in[7], nullptr, DATT, DM, (bf16_t*)(ws + WS_BT3), DM, scr, r, lane); continue; } r -= I_OB;
        if (r < I_MIX) { p0_transpose_item<RM_ID>(a.in[8], nullptr, DM, DM, (bf16_t*)(ws + WS_WMIX), 0, scr, r, lane); continue; } r -= I_MIX;
        if (r < I_UP) { p0_transpose_item<RM_UP>(a.in[10], a.in[9], DM, 2 * DFF, (bf16_t*)(ws + WS_WUP), 0, scr, r, lane); continue; } r -= I_UP;
        p0_transpose_item<RM_ID>(a.in[13], nullptr, DFF, DM, (bf16_t*)(ws + WS_WDOWN), 0, scr, r, lane);
    }
    const float* x = a.in[0]; bf16_t* xb = (bf16_t*)(ws + WS_XB); float* rstd1 = (float*)(ws + WS_RSTD1);
    for (int m = gw; m < SEQ; m += NGW) {
        const f32x4* xr = (const f32x4*)(x + (size_t)m * DM) + lane; f32x4 v[8]; float s = 0.f;
#pragma unroll
        for (int j = 0; j < 8; ++j) { v[j] = xr[64 * j]; s += (v[j][0] * v[j][0] + v[j][1] * v[j][1]) + (v[j][2] * v[j][2] + v[j][3] * v[j][3]); }
        s = wave_sum(s);
        u32x2* o8 = (u32x2*)(xb + (size_t)m * DM) + lane;
#pragma unroll
        for (int j = 0; j < 8; ++j) { u32x2 w; w.x = cvt_pk_bf16(v[j][0], v[j][1]); w.y = cvt_pk_bf16(v[j][2], v[j][3]); o8[64 * j] = w; }
        if (lane == 0) rstd1[m] = 1.0f / sqrtf(s * (1.0f / DM) + EPS);
    }
    const int gt = vcu * NTHREADS + tid, NGT = G * NTHREADS;
    float* cosT = (float*)(ws + WS_COS); float* sinT = (float*)(ws + WS_SIN);
    for (int idx = gt; idx < SEQ * 32; idx += NGT) {
        const int t = idx >> 5, i = idx & 31;
        double f = 1.0; for (int k = 0; k < i; ++k) f *= 0.7498942093324559;
        const float inv = (float)f; const float angf = (float)t * inv;
        const double ang = (double)angf;
        const double kq = __builtin_rint(ang * 0.6366197723675814);
        double y = __builtin_fma(-kq, 1.5707963267948966, ang); y = __builtin_fma(-kq, 6.123233995736766e-17, y);
        const double y2 = y * y;
        double sp = -1.0 / 1307674368000.0; sp = sp * y2 + 1.0 / 6227020800.0; sp = sp * y2 - 1.0 / 39916800.0; sp = sp * y2 + 1.0 / 362880.0; sp = sp * y2 - 1.0 / 5040.0; sp = sp * y2 + 1.0 / 120.0; sp = sp * y2 - 1.0 / 6.0; sp = sp * y2 + 1.0; sp = sp * y;
        double cp = 1.0 / 20922789888000.0; cp = cp * y2 - 1.0 / 87178291200.0; cp = cp * y2 + 1.0 / 479001600.0; cp = cp * y2 - 1.0 / 3628800.0; cp = cp * y2 + 1.0 / 40320.0; cp = cp * y2 - 1.0 / 720.0; cp = cp * y2 + 1.0 / 24.0; cp = cp * y2 - 0.5; cp = cp * y2 + 1.0;
        const int q = ((int)kq) & 3;
        const double sv = (q == 0) ? sp : (q == 1) ? cp : (q == 2) ? -sp : -cp;
        const double cv = (q == 0) ? cp : (q == 1) ? -sp : (q == 2) ? -cp : sp;
        cosT[idx] = (float)cv; sinT[idx] = (float)sv;
    }
    float* ssq2 = (float*)(ws + WS_SSQ2); float* ssq3 = (float*)(ws + WS_SSQ3);
    for (int idx = gt; idx < SEQ; idx += NGT) { ssq2[idx] = 0.f; ssq3[idx] = 0.f; }
}

__device__ __forceinline__ void load_cv(const bf16_t* z, int t, int c0, float (&cv)[8]) {
    if (t < 0 || t >= SEQ) {
#pragma unroll
        for (int j = 0; j < 8; ++j) cv[j] = 0.f;
        return;
    }
    float c[8], v[8]; unpack8(*(const u32x4*)(z + (size_t)t * DIN + C_CA + c0), c); unpack8(*(const u32x4*)(z + (size_t)t * DIN + C_VA + c0), v);
#pragma unroll
    for (int j = 0; j < 8; ++j) cv[j] = c[j] * v[j];
}
__device__ __forceinline__ void phase_mixer(const Args& a, int lane, int gw, int NGW) {
    const bf16_t* z = (const bf16_t*)(a.ws + WS_Z); bf16_t* ya = (bf16_t*)a.out; const float* cw = a.in[4];
    for (int it = gw; it < (SEQ / 16) * 2; it += NGW) {
        const int t0 = (it >> 1) * 16, c0 = (it & 1) * 512 + 8 * lane;
        float w0[8], w1[8], w2[8];
#pragma unroll
        for (int j = 0; j < 8; ++j) { w0[j] = cw[c0 + j]; w1[j] = cw[DCONV + c0 + j]; w2[j] = cw[2 * DCONV + c0 + j]; }
        float prev[8], cur[8], nxt[8];
        load_cv(z, t0 - 1, c0, prev); load_cv(z, t0, c0, cur);
        for (int t = t0; t < t0 + 16; ++t) {
            load_cv(z, t + 1, c0, nxt);
            float b[8]; unpack8(*(const u32x4*)(z + (size_t)t * DIN + C_BA + c0), b);
            float o[8];
#pragma unroll
            for (int j = 0; j < 8; ++j) { o[j] = b[j] * (w0[j] * prev[j] + w1[j] * cur[j] + w2[j] * nxt[j]); prev[j] = cur[j]; cur[j] = nxt[j]; }
            *(u32x4*)(ya + (size_t)t * DCONV + c0) = pack8(o);
        }
    }
}

constexpr int KROW = 144, VROW = 656, KWIN = 320, LDS_KB = KWIN * KROW;
__device__ __forceinline__ void attn_unit(LAS unsigned char* lds, const bf16_t* z, const bf16_t* vT, bf16_t* att, const float* sink, int kh, int qb, int tid) {
    asm volatile("" : "+v"(tid));
    const int lane = tid & 63, wid = __builtin_amdgcn_readfirstlane(tid >> 6), l31 = lane & 31, hi = lane >> 5;
    const int q0 = qb * 64;
#pragma unroll
    for (int i = 0; i < 5; ++i) {
        const int id = tid + 512 * i, r = id >> 3, ch = id & 7, t = q0 - 128 + r;
        u32x4 v = (u32x4){0u, 0u, 0u, 0u};
        if (t >= 0 && t < SEQ) v = *(const u32x4*)(z + (size_t)t * DIN + C_K + 64 * kh + 8 * ch);
        *(LAS u32x4*)(lds + r * KROW + ch * 16) = v;
    }
#pragma unroll
    for (int i = 0; i < 5; ++i) {
        const int id = tid + 512 * i, d = id / 40, ch = id - d * 40, t = q0 - 128 + 8 * ch;
        u32x4 v = (u32x4){0u, 0u, 0u, 0u};
        if (t >= 0 && t < SEQ) v = *(const u32x4*)(vT + (size_t)(64 * kh + d) * SEQ + t);
        *(LAS u32x4*)(lds + LDS_KB + d * VROW + ch * 16) = v;
    }
    __syncthreads();
    const int g = wid >> 1, sb = wid & 1, head = 4 * kh + g, q0w = q0 + 32 * sb;
    bf16x8 qr[4];
#pragma unroll
    for (int ds = 0; ds < 4; ++ds) qr[ds] = *(const bf16x8*)(z + (size_t)(q0w + l31) * DIN + C_Q + head * 64 + 16 * ds + 8 * hi);
    const int pi = (l31 & 0x13) | ((l31 & 4) << 1) | ((l31 & 8) >> 1);
    f32x16 s[9];
#pragma unroll
    for (int tl = 0; tl < 9; ++tl) {
        const LAS unsigned char* kp = lds + (32 * (sb + tl) + pi) * KROW + 16 * hi;
        f32x16 acc = (f32x16){0.f, 0.f, 0.f, 0.f, 0.f, 0.f, 0.f, 0.f, 0.f, 0.f, 0.f, 0.f, 0.f, 0.f, 0.f, 0.f};
#pragma unroll
        for (int ds = 0; ds < 4; ++ds) { const bf16x8 kf = *(const LAS bf16x8*)(kp + 32 * ds); acc = __builtin_amdgcn_mfma_f32_32x32x16_bf16(kf, qr[ds], acc, 0, 0, 0); }
        s[tl] = acc;
    }
    const float sinkl = sink[head] * LOG2E;
    float mx = sinkl;
    if (q0 < 128 || q0 + 192 > SEQ) {
        const int qpos = q0w + l31;
#pragma unroll
        for (int tl = 0; tl < 9; ++tl)
#pragma unroll
            for (int r = 0; r < 16; ++r) {
                const int kpos = q0w - 128 + 32 * tl + 16 * (r >> 3) + 8 * hi + (r & 7);
                const int dlt = kpos - qpos;
                const bool ok = (dlt >= -128) && (dlt <= 128) && (kpos >= 0) && (kpos < SEQ);
                const float v = ok ? s[tl][r] : -INFINITY;
                s[tl][r] = v; mx = fmaxf(mx, v);
            }
    } else {
#pragma unroll
        for (int r = 0; r < 16; ++r) {
            const int kk = 16 * (r >> 3) + 8 * hi + (r & 7);
            s[0][r] = (kk >= l31) ? s[0][r] : -INFINITY;
            s[8][r] = (kk <= l31) ? s[8][r] : -INFINITY;
        }
#pragma unroll
        for (int tl = 0; tl < 9; ++tl)
#pragma unroll
            for (int r = 0; r < 16; ++r) mx = fmaxf(mx, s[tl][r]);
    }
    mx = fmaxf(mx, __shfl_xor(mx, 32));
    float sum = 0.f;
#pragma unroll
    for (int tl = 0; tl < 9; ++tl)
#pragma unroll
        for (int r = 0; r < 16; ++r) { const float p = __builtin_amdgcn_exp2f(s[tl][r] - mx); s[tl][r] = p; sum += p; }
    sum += __shfl_xor(sum, 32);
    const float inv = 1.0f / (sum + __builtin_amdgcn_exp2f(sinkl - mx));
    f32x16 o[2];
    o[0] = (f32x16){0.f, 0.f, 0.f, 0.f, 0.f, 0.f, 0.f, 0.f, 0.f, 0.f, 0.f, 0.f, 0.f, 0.f, 0.f, 0.f}; o[1] = o[0];
#pragma unroll
    for (int tl = 0; tl < 9; ++tl)
#pragma unroll
        for (int s2 = 0; s2 < 2; ++s2) {
            u32x4 pw; pw.x = cvt_pk_bf16(s[tl][8 * s2 + 0], s[tl][8 * s2 + 1]); pw.y = cvt_pk_bf16(s[tl][8 * s2 + 2], s[tl][8 * s2 + 3]);
            pw.z = cvt_pk_bf16(s[tl][8 * s2 + 4], s[tl][8 * s2 + 5]); pw.w = cvt_pk_bf16(s[tl][8 * s2 + 6], s[tl][8 * s2 + 7]);
            const bf16x8 pb = __builtin_bit_cast(bf16x8, pw);
#pragma unroll
            for (int db = 0; db < 2; ++db) {
                const bf16x8 vf = *(const LAS bf16x8*)(lds + LDS_KB + (32 * db + l31) * VROW + (32 * (sb + tl) + 16 * s2 + 8 * hi) * 2);
                o[db] = __builtin_amdgcn_mfma_f32_32x32x16_bf16(vf, pb, o[db], 0, 0, 0);
            }
        }
    bf16_t* orow = att + (size_t)(q0w + l31) * DATT + head * 64;
#pragma unroll
    for (int db = 0; db < 2; ++db)
#pragma unroll
        for (int rg = 0; rg < 4; ++rg) {
            u32x2 w; w.x = cvt_pk_bf16(o[db][4 * rg + 0] * inv, o[db][4 * rg + 1] * inv); w.y = cvt_pk_bf16(o[db][4 * rg + 2] * inv, o[db][4 * rg + 3] * inv);
            *(u32x2*)(orow + 32 * db + 8 * rg + 4 * hi) = w;
        }
    __syncthreads();
}

__device__ __forceinline__ void load_edge(const bf16_t* edge, int slab, int e, int bj, int ch, float (&f)[8]) {
    if (slab < 0 || slab >= SEQ / 64) {
#pragma unroll
        for (int j = 0; j < 8; ++j) f[j] = 0.f;
        return;
    }
    unpack8(*(const u32x4*)(edge + ((size_t)((slab * 4 + e) * 2 + bj)) * DFF + ch), f);
}
__device__ __forceinline__ void phase_fixup(const Args& a, int gt, int NGT) {
    const bf16_t* edge = (const bf16_t*)(a.ws + WS_EDGE); bf16_t* act = (bf16_t*)(a.ws + WS_ACT); const float* cw = a.in[11]; const float* cb = a.in[12];
    for (int idx = gt; idx < (SEQ / 64) * 2 * (DFF / 8); idx += NGT) {
        const int rowi = idx / (DFF / 8), chunk = idx - rowi * (DFF / 8), slab = rowi >> 1, last = rowi & 1, ch = 8 * chunk;
        const int row = 64 * slab + (last ? 63 : 0);
        float o[2][8];
#pragma unroll
        for (int bj = 0; bj < 2; ++bj) {
            float p[8], c[8], n[8];
            if (last) { load_edge(edge, slab, 2, bj, ch, p); load_edge(edge, slab, 3, bj, ch, c); load_edge(edge, slab + 1, 0, bj, ch, n); }
            else      { load_edge(edge, slab - 1, 3, bj, ch, p); load_edge(edge, slab, 0, bj, ch, c); load_edge(edge, slab, 1, bj, ch, n); }
            const int pc = bj * DFF + ch;
#pragma unroll
            for (int j = 0; j < 8; ++j) o[bj][j] = cw[pc + j] * p[j] + cw[2 * DFF + pc + j] * c[j] + cw[4 * DFF + pc + j] * n[j] + cb[pc + j];
        }
        float r[8];
#pragma unroll
        for (int j = 0; j < 8; ++j) r[j] = o[0][j] * sigmoidf_(o[0][j]) * o[1][j];
        *(u32x4*)(act + (size_t)row * DFF + ch) = pack8(r);
    }
}

#define XB_TMO      128
#define XB_XCNT(j)  (256  + 64 * (j))
#define XB_XSUB(j)  (1280 + 64 * (j))
#define XB_XGEN(j)  (2304 + 64 * (j))
#define XB_TOP      3328
#define XB_TOPGEN   3392
#define XCD_BAR_WORDS 3456
#define XB_SPIN_CAP (1u << 18)

__device__ __forceinline__ unsigned xb_ld(unsigned* p)              { return __hip_atomic_load(p, __ATOMIC_RELAXED, __HIP_MEMORY_SCOPE_AGENT); }
__device__ __forceinline__ unsigned xb_add(unsigned* p, unsigned v) { return __hip_atomic_fetch_add(p, v, __ATOMIC_RELAXED, __HIP_MEMORY_SCOPE_AGENT); }
__device__ __forceinline__ unsigned xb_xcc_id() { return (unsigned)__builtin_amdgcn_s_getreg((3 << 11) | 20) & 0xFu; }
#define XB_SPIN(cond, bar) do { unsigned _sp = 0; while (cond) { __builtin_amdgcn_s_sleep(1); \
    if ((++_sp & 255u) == 0u) { if (xb_ld(&(bar)[XB_TMO])) break; if (_sp > XB_SPIN_CAP) { atomicAdd(&(bar)[XB_TMO], 1u); break; } } } } while (0)

struct XcdBarrier {
    unsigned* bar; unsigned x;
    volatile LAS unsigned* st;
};

__device__ __forceinline__ XcdBarrier xcd_barrier_post(unsigned* bar, volatile LAS unsigned* st) {
    XcdBarrier b; b.bar = bar; b.x = xb_xcc_id(); b.st = st;
    if (threadIdx.x == 0) (void)xb_add(&bar[XB_XCNT(b.x)], 1u);
    return b;
}
__device__ __forceinline__ void xcd_barrier_complete(unsigned* bar, unsigned x, unsigned& nloc, unsigned& nx) {
    const unsigned G = gridDim.x * gridDim.y * gridDim.z;
    unsigned sum, cnt, mine, sp = 0u;
    for (;;) {
        sum = 0u; cnt = 0u; mine = 0u;
#pragma unroll
        for (unsigned j = 0; j < 16; ++j) { const unsigned c = xb_ld(&bar[XB_XCNT(j)]); sum += c; cnt += (c > 0u) ? 1u : 0u; mine = (j == x) ? c : mine; }
        if (sum == G) break;
        __builtin_amdgcn_s_sleep(1);
        if ((++sp & 255u) == 0u) { if (xb_ld(&bar[XB_TMO])) break; if (sp > XB_SPIN_CAP) { atomicAdd(&bar[XB_TMO], 1u); break; } }
    }
    nloc = mine > 0u ? mine : 1u; nx = cnt > 0u ? cnt : 1u;
}

__device__ __forceinline__ void xcd_barrier(const XcdBarrier& b) {
    asm volatile("s_waitcnt vmcnt(0)" ::: "memory");
    __syncthreads();
    if (threadIdx.x == 0) {
        unsigned* bar = b.bar;
        __builtin_amdgcn_s_waitcnt(0);
        unsigned nloc = b.st[0], nx = b.st[1];
        if (nloc == 0u) { xcd_barrier_complete(bar, b.x, nloc, nx); b.st[0] = nloc; b.st[1] = nx; }
        const unsigned old = xb_add(&bar[XB_XSUB(b.x)], 1u);
        const unsigned gen = old / nloc;
        if (old + 1u == (gen + 1u) * nloc) {
            __builtin_amdgcn_fence(__ATOMIC_RELEASE, "agent");
            asm volatile("s_waitcnt vmcnt(0)" ::: "memory");
            const unsigned og = xb_add(&bar[XB_TOP], 1u);
            const unsigned tg = og / nx;
            if (og + 1u == (tg + 1u) * nx) xb_add(&bar[XB_TOPGEN], 1u);
            else XB_SPIN(xb_ld(&bar[XB_TOPGEN]) == tg, bar);
            __builtin_amdgcn_fence(__ATOMIC_ACQUIRE, "agent");
            xb_add(&bar[XB_XGEN(b.x)], 1u);
            asm volatile("s_waitcnt vmcnt(0)" ::: "memory");
        } else {
            XB_SPIN(xb_ld(&bar[XB_XGEN(b.x)]) == gen, bar);
            __builtin_amdgcn_fence(__ATOMIC_ACQUIRE, "agent");
            asm volatile("s_waitcnt vmcnt(0)" ::: "memory");
        }
    }
    __syncthreads();
}

constexpr size_t WS_BAR = 262144;
__device__ __forceinline__ void grid_barrier(unsigned* cnt, unsigned target) {
    asm volatile("s_waitcnt vmcnt(0)" ::: "memory");
    __syncthreads();
    if (threadIdx.x == 0) {
        __builtin_amdgcn_fence(__ATOMIC_RELEASE, "agent");
        asm volatile("s_waitcnt vmcnt(0)" ::: "memory");
        __hip_atomic_fetch_add(cnt, 1u, __ATOMIC_RELAXED, __HIP_MEMORY_SCOPE_AGENT);
        while (__hip_atomic_load(cnt, __ATOMIC_RELAXED, __HIP_MEMORY_SCOPE_AGENT) < target) __builtin_amdgcn_s_sleep(2);
        __builtin_amdgcn_fence(__ATOMIC_ACQUIRE, "agent");
        asm volatile("s_waitcnt vmcnt(0)" ::: "memory");
    }
    __syncthreads();
}

__global__ void __launch_bounds__(NTHREADS, 2) fwd_megakernel(Args args) {
    extern __shared__ __attribute__((aligned(16))) unsigned char lds_raw[];
    LAS unsigned char* lds = (LAS unsigned char*)lds_raw;
    const int tid = threadIdx.x, lane = tid & 63, wave = __builtin_amdgcn_readfirstlane(tid >> 6);
    const int G = gridDim.x, bx = blockIdx.x;
    const int vcu = (G % 8 == 0) ? (bx % 8) * (G / 8) + bx / 8 : bx;
    const int gw = vcu * NWAVES + wave, NGW = G * NWAVES;
    unsigned char* ws = args.ws;
    const int lo = args.ph_lo, hi = args.ph_hi;
#define IN(k) (lo <= (k) && (k) < hi)
    unsigned* barw = (unsigned*)(ws + WS_BAR);
    volatile LAS unsigned* MISC = (volatile LAS unsigned*)(lds + (LDS_BYTES - 64));
    if (tid == 0) { MISC[0] = 0u; MISC[1] = 0u; }
    __syncthreads();
    XcdBarrier bar; bar.bar = barw; bar.x = 0; bar.st = nullptr;
#define SEAM(k) do { if (IN(k) && IN((k) + 1)) { xcd_barrier(bar); } } while (0)

    if (IN(0)) {
        if (bx == 0) { for (int i = tid; i < XCD_BAR_WORDS; i += NTHREADS) __hip_atomic_store(barw + i, 0u, __ATOMIC_RELAXED, __HIP_MEMORY_SCOPE_AGENT); }
        phase_prologue(args, lds, tid, lane, wave, vcu, G);
#ifdef PROBE_DUP_P0
        __syncthreads(); phase_prologue(args, lds, tid, lane, wave, vcu, G);
#endif
    }
    if (IN(0) && IN(1)) { cg::this_grid().sync(); bar = xcd_barrier_post(barw, MISC); }
    if (IN(1)) {
        Gemm g{(const bf16_t*)(ws + WS_XB), (const bf16_t*)(ws + WS_WIN), SEQ, DIN, DM}; Sched1 S; S.init(G, bx);
        Epi1 E{(bf16_t*)(ws + WS_Z), (bf16_t*)(ws + WS_VT), (const float*)(ws + WS_RSTD1), (const float*)(ws + WS_COS), (const float*)(ws + WS_SIN), args.in[3]};
#ifdef PROBE_DUP_G1
        _Pragma("unroll 1") for (int rep = 0; rep < (hi > 8 ? 2 : 1); ++rep) { __syncthreads(); pg8::gemm_phase<Epi1, Sched1, true, true>(lds, g, S, E); }
#else
        pg8::gemm_phase<Epi1, Sched1, true, true>(lds, g, S, E);
#endif
    }
    SEAM(1);
    if (IN(2)) {
        phase_mixer(args, lane, gw, NGW);
        const bf16_t* z = (const bf16_t*)(ws + WS_Z); const bf16_t* vT = (const bf16_t*)(ws + WS_VT); bf16_t* att = (bf16_t*)args.out + (size_t)SEQ * DCONV;
        for (int u = vcu; u < NKV * (SEQ / 64); u += G) attn_unit(lds, z, vT, att, args.in[6], u & 3, u >> 2, tid);
#ifdef PROBE_DUP_ATT
        for (int u = vcu; u < NKV * (SEQ / 64); u += G) attn_unit(lds, z, vT, att, args.in[6], u & 3, u >> 2, tid);
#endif
#ifdef PROBE_DUP_MIX
        phase_mixer(args, lane, gw, NGW);
#endif
    }
    SEAM(2);
    if (IN(3)) {
        Gemm g{(const bf16_t*)args.out, (const bf16_t*)(ws + WS_BT3), 2 * SEQ, 2 * DM, DCONV}; Sched3 S; S.init(G, bx);
        Epi3 E{(const bf16_t*)(ws + WS_Z), (bf16_t*)args.out + (size_t)2 * SEQ * DCONV, (bf16_t*)(ws + WS_MB)};
#ifdef PROBE_DUP_G3
        _Pragma("unroll 1") for (int rep = 0; rep < (hi > 8 ? 2 : 1); ++rep) { __syncthreads(); pg8::gemm_phase<Epi3, Sched3, true, true>(lds, g, S, E); }
#else
        pg8::gemm_phase<Epi3, Sched3, true, true>(lds, g, S, E);
#endif
    }
    SEAM(3);
    if (IN(4)) {
        Gemm g{(const bf16_t*)(ws + WS_MB), (const bf16_t*)(ws + WS_WMIX), SEQ, DM, DM}; pg8::StaticOrder S; S.init(SEQ, DM, G, bx);
        EpiRes E{args.in[0], args.out, (bf16_t*)(ws + WS_H1B), (float*)(ws + WS_SSQ2)};
        pg8::gemm_phase<EpiRes, pg8::StaticOrder, true, true>(lds, g, S, E);
    }
    SEAM(4);
    if (IN(5)) {
        Gemm g{(const bf16_t*)(ws + WS_H1B), (const bf16_t*)(ws + WS_WUP), SEQ, 2 * DFF, DM}; pg8::StaticOrder S; S.init(SEQ, 2 * DFF, G, bx);
        Epi5F E{(bf16_t*)(ws + WS_ACT), (bf16_t*)(ws + WS_EDGE), (const float*)(ws + WS_SSQ2), args.in[11], args.in[12]};
        pg8::gemm_phase<Epi5F, pg8::StaticOrder, true, true>(lds, g, S, E);
    }
    SEAM(5);
    if (IN(6)) { phase_fixup(args, vcu * NTHREADS + tid, G * NTHREADS); }
    SEAM(6);
    if (IN(7)) {
        Gemm g{(const bf16_t*)(ws + WS_ACT), (const bf16_t*)(ws + WS_WDOWN), SEQ, DM, DFF}; pg8::StaticOrder S; S.init(SEQ, DM, G, bx);
        EpiRes E{args.out, args.out, nullptr, (float*)(ws + WS_SSQ3)};
        pg8::gemm_phase<EpiRes, pg8::StaticOrder, true, true>(lds, g, S, E);
    }
    SEAM(7);
#ifdef PROBE_BARS
    for (int rep = 0; rep < 10; ++rep) { xcd_barrier(bar); }
#endif
    if (IN(8)) {
        const float* ssq3 = (const float*)(ws + WS_SSQ3); const float* gf = args.in[14];
        for (int m = gw; m < SEQ; m += NGW) {
            const float rs = 1.0f / sqrtf(ssq3[m] * (1.0f / DM) + EPS);
            f32x4* xr = (f32x4*)(args.out + (size_t)m * DM) + lane; const f32x4* gr = (const f32x4*)gf + lane;
#pragma unroll
            for (int j = 0; j < 8; ++j) { const f32x4 v = xr[64 * j] * rs * gr[64 * j]; xr[64 * j] = v; }
        }
    }
#undef IN
#undef SEAM
}

constexpr int N_PHASES = 9;
extern "C" void kernel_launch(void* const* d_in, const int* in_sizes, int n_in, void* d_out, int out_size, void* d_ws, size_t ws_size, hipStream_t stream) {
    static int grid = 0;
    if (grid == 0) {
        if (n_in != 15 || in_sizes[0] != SEQ * DM || out_size != SEQ * DM || ws_size < WS_END) { fprintf(stderr, "kernel_launch: unexpected shapes / workspace (n_in %d, in0 %d, out %d, ws %zu)\n", n_in, n_in > 0 ? in_sizes[0] : -1, out_size, ws_size); grid = -1; return; }
        int dev = 0, cus = 0;
        if (hipGetDevice(&dev) != hipSuccess || hipDeviceGetAttribute(&cus, hipDeviceAttributeMultiprocessorCount, dev) != hipSuccess) { grid = -1; return; }
        if (hipFuncSetAttribute((const void*)fwd_megakernel, hipFuncAttributeMaxDynamicSharedMemorySize, LDS_BYTES) != hipSuccess) { fprintf(stderr, "kernel_launch: hipFuncSetAttribute failed\n"); grid = -1; return; }
        int per_cu = 0;
        if (hipOccupancyMaxActiveBlocksPerMultiprocessor(&per_cu, (const void*)fwd_megakernel, NTHREADS, LDS_BYTES) != hipSuccess || per_cu < 1) { fprintf(stderr, "kernel_launch: occupancy query says %d blocks per CU\n", per_cu); (void)hipGetLastError(); }
        grid = cus;
    }
    if (grid < 0) return;
    Args a{};
    for (int i = 0; i < 15; ++i) a.in[i] = (const float*)d_in[i];
    a.out = (float*)d_out; a.ws = (unsigned char*)d_ws;
#if MK_N_LAUNCHES == 1
    a.ph_lo = 0; a.ph_hi = N_PHASES;
    void* kargs[] = {&a};
    hipError_t e = hipLaunchCooperativeKernel((const void*)fwd_megakernel, dim3(grid), dim3(NTHREADS), kargs, LDS_BYTES, stream);
    if (e != hipSuccess) fprintf(stderr, "kernel_launch: cooperative launch failed: %s (grid %d)\n", hipGetErrorString(e), grid);
#ifdef PROBE_PHASE
    {
        Args b = a; b.ph_lo = PROBE_PHASE; b.ph_hi = PROBE_PHASE + (PROBE_PHASE >= 0 ? 1 : 0); b.out = (float*)((unsigned char*)d_ws + 160 * MiB);
        hipLaunchKernelGGL(fwd_megakernel, dim3(grid), dim3(NTHREADS), LDS_BYTES, stream, b);
    }
#endif
#else
    for (int ph = 0; ph < N_PHASES; ++ph) {
        a.ph_lo = ph; a.ph_hi = ph + 1;
        hipLaunchKernelGGL(fwd_megakernel, dim3(grid), dim3(NTHREADS), LDS_BYTES, stream, a);
    }
#endif
}
```
